# Optimizing an MI355X kernel written in HIP

```python
import math
import jax, jax.numpy as jnp
from jax import lax
import numpy as np

D_MODEL = 2048
BATCH = 2
SEQ = 16384
DEPTH = 4
DEC_BATCH = 8
DEC_SEQ = 2048
PAST_LEN = 128

GRID_W = 64
HEAD_DIM = 128
NA_WIDTH = D_MODEL // 2
NA_HEADS = NA_WIDTH // HEAD_DIM
NA_MAX_WR = 8
NA_WC = 16
DIFF_WIDTH = D_MODEL - NA_WIDTH
DIFF_HEAD_DIM = 128
DIFF_HEADS = DIFF_WIDTH // (2 * DIFF_HEAD_DIM)
ROPE_THETA = 500000.0
ROPE_DIM = DIFF_HEAD_DIM // 4
Q_BLOCK = 128
IN_PROJ_WIDTH = 3 * D_MODEL
S5_GROUP = 16
S5_GROUPS = D_MODEL // S5_GROUP
S5_STATE = 64
FFN_HIDDEN = -(-8 * D_MODEL // (3 * 256)) * 256
N_ATTN_LAYERS = (DEPTH + 1) // 2
N_SSM_LAYERS = DEPTH // 2
NORM_EPS = 1e-6

kernel_name = "hybrid_na_diffattn_s5_encoder"


def _rmsnorm(x, g):
    x32 = x.astype(jnp.float32)
    y = x32 * lax.rsqrt(jnp.mean(x32 * x32, axis=-1, keepdims=True) + NORM_EPS)
    return (y * g.astype(jnp.float32)).astype(x.dtype)


def _modulate(h, shift, scale):
    return h * (1 + scale) + shift


def _rotary_tables(t):
    inv_freq = ROPE_THETA ** (-jnp.arange(0, ROPE_DIM, 2, dtype=jnp.float32) / ROPE_DIM)
    ang = jnp.arange(t, dtype=jnp.float32)[:, None] * inv_freq[None, :]
    return jnp.cos(ang), jnp.sin(ang)


def _partial_rotary(x, cos, sin):
    half = ROPE_DIM // 2
    cos = cos[None, :, None, None, :]
    sin = sin[None, :, None, None, :]
    xr = x[..., :ROPE_DIM].astype(jnp.float32)
    x1, x2 = xr[..., :half], xr[..., half:]
    rot = jnp.concatenate([x1 * cos - x2 * sin, x2 * cos + x1 * sin], axis=-1).astype(x.dtype)
    return jnp.concatenate([rot, x[..., ROPE_DIM:]], axis=-1)


def _neighbourhood_attention(q, k, v, rpb):
    b, t, h, d = q.shape
    rows = t // GRID_W
    wr = min(NA_MAX_WR, rows)
    n_keys = wr * NA_WC
    scale = 1.0 / math.sqrt(d)
    col = jnp.arange(GRID_W)
    col_start = jnp.clip(col - NA_WC // 2, 0, GRID_W - NA_WC)
    key_col = col_start[:, None] + jnp.arange(NA_WC)[None, :]
    dc_idx = key_col - col[:, None] + (NA_WC - 1)

    def row_fn(r):
        row_start = jnp.clip(r - wr // 2, 0, rows - wr)
        key_row = row_start + jnp.arange(wr)
        idx = (key_row[None, :, None] * GRID_W + key_col[:, None, :]).reshape(GRID_W, n_keys)
        q_row = lax.dynamic_slice_in_dim(q, r * GRID_W, GRID_W, axis=1)
        k_win = jnp.take(k, idx, axis=1)
        v_win = jnp.take(v, idx, axis=1)
        dr_idx = key_row - r + (NA_MAX_WR - 1)
        bias = rpb[:, dr_idx[None, :, None], dc_idx[:, None, :]]
        bias = bias.reshape(h, GRID_W, n_keys).transpose(1, 0, 2).astype(jnp.float32)
        s = jnp.einsum('bqhd,bqkhd->bqhk', q_row, k_win).astype(jnp.float32) * scale + bias
        p = jax.nn.softmax(s, axis=-1).astype(v.dtype)
        return jnp.einsum('bqhk,bqkhd->bqhd', p, v_win)

    out = lax.map(row_fn, jnp.arange(rows))
    return out.transpose(1, 0, 2, 3, 4).reshape(b, t, h * d)


def _differential_attention(q, k, v, lam, subln, lambda_init):
    b, t, h, _, d = q.shape
    cos, sin = _rotary_tables(t)
    q = _partial_rotary(q, cos, sin)
    k = _partial_rotary(k, cos, sin)
    scale = 1.0 / math.sqrt(d)
    nb = t // Q_BLOCK
    qb = q.reshape(b, nb, Q_BLOCK, h, 2, d).transpose(1, 0, 2, 3, 4, 5)

    def block_fn(q_blk):
        s = jnp.einsum('bqhnd,bkhnd->nbhqk', q_blk, k).astype(jnp.float32) * scale
        p = jax.nn.softmax(s, axis=-1)
        w = (p[0] - lam * p[1]).astype(v.dtype)
        return jnp.einsum('bhqk,bkhe->bqhe', w, v)

    out = lax.map(block_fn, qb)
    out = out.transpose(1, 0, 2, 3, 4).reshape(b, t, h, 2 * d)
    out = _rmsnorm(out, subln) * (1.0 - lambda_init)
    return out.reshape(b, t, h * 2 * d)


def _attention_mixer(h, w_in, w_out, rpb, diff_lambda, subln, lambda_init):
    b, t, _ = h.shape
    qa, ka, va, qb, kb, vb = jnp.split(h @ w_in, 6, axis=-1)
    out_a = _neighbourhood_attention(
        qa.reshape(b, t, NA_HEADS, HEAD_DIM),
        ka.reshape(b, t, NA_HEADS, HEAD_DIM),
        va.reshape(b, t, NA_HEADS, HEAD_DIM), rpb)
    lp = diff_lambda.astype(jnp.float32)
    lam = jnp.exp(jnp.sum(lp[0] * lp[1])) - jnp.exp(jnp.sum(lp[2] * lp[3])) + lambda_init
    out_b = _differential_attention(
        qb.reshape(b, t, DIFF_HEADS, 2, DIFF_HEAD_DIM),
        kb.reshape(b, t, DIFF_HEADS, 2, DIFF_HEAD_DIM),
        vb.reshape(b, t, DIFF_HEADS, 2 * DIFF_HEAD_DIM), lam, subln, lambda_init)
    return jnp.concatenate([out_a, out_b], axis=-1) @ w_out


def _linear_combine(left, right):
    a_l, b_l = left
    a_r, b_r = right
    return (a_r * a_l, a_r * b_l + b_r)


def _s5_scan(u, a_re, a_im, log_dt, b_re, b_im, c_re, c_im, reverse):
    f32 = jnp.float32
    lam = lax.complex(a_re.astype(f32), a_im.astype(f32))
    dt = jnp.exp(log_dt.astype(f32))[:, None]
    lam_bar = jnp.exp(lam * dt)
    b_bar = ((lam_bar - 1.0) / lam)[:, :, None] * lax.complex(b_re.astype(f32), b_im.astype(f32))
    bu = jnp.einsum('btgc,gpc->btgp', u.astype(jnp.complex64), b_bar)
    decay = jnp.broadcast_to(lam_bar, bu.shape)
    _, states = lax.associative_scan(_linear_combine, (decay, bu), axis=1, reverse=reverse)
    c_mat = lax.complex(c_re.astype(f32), c_im.astype(f32))
    return jnp.real(jnp.einsum('btgp,gcp->btgc', states, c_mat))


def _s5_mixer(h, a_re, a_im, log_dt, b_re, b_im, c_re, c_im, d_skip, w_glu):
    b, t, d = h.shape
    u = h.astype(jnp.float32).reshape(b, t, S5_GROUPS, S5_GROUP)
    y = d_skip.astype(jnp.float32).reshape(S5_GROUPS, S5_GROUP) * u
    for direction, reverse in ((0, False), (1, True)):
        y = y + _s5_scan(u, a_re[direction], a_im[direction], log_dt[direction],
                         b_re[direction], b_im[direction], c_re[direction], c_im[direction], reverse)
    y = jax.nn.gelu(y.reshape(b, t, d)).astype(h.dtype)
    val, gate = jnp.split(y @ w_glu, 2, axis=-1)
    return val * jax.nn.sigmoid(gate)


def _swiglu(h, w_in, w_out):
    g, u = jnp.split(h @ w_in, 2, axis=-1)
    return (jax.nn.silu(g) * u) @ w_out


def _trunk(x, c, w_ada, b_ada, g_pre_mix, g_post_mix, g_pre_ffn, g_post_ffn,
           w_ffn_in, w_ffn_out, w_attn_in, w_attn_out, na_rpb, diff_lambda, diff_subln,
           s5_a_re, s5_a_im, s5_log_dt, s5_b_re, s5_b_im, s5_c_re, s5_c_im, s5_d, s5_w_glu):
    for li in range(DEPTH):
        ada = jax.nn.silu(c) @ w_ada[li] + b_ada[li]
        sh_m, sc_m, gt_m, sh_f, sc_f, gt_f = jnp.split(ada[:, None, :], 6, axis=-1)
        h = _modulate(_rmsnorm(x, g_pre_mix[li]), sh_m, sc_m)
        j = li // 2
        if li % 2 == 0:
            lambda_init = 0.8 - 0.6 * math.exp(-0.3 * li)
            mix = _attention_mixer(h, w_attn_in[j], w_attn_out[j], na_rpb[j],
                                   diff_lambda[j], diff_subln[j], lambda_init)
        else:
            mix = _s5_mixer(h, s5_a_re[j], s5_a_im[j], s5_log_dt[j], s5_b_re[j], s5_b_im[j],
                            s5_c_re[j], s5_c_im[j], s5_d[j], s5_w_glu[j])
        x = x + gt_m * _rmsnorm(mix, g_post_mix[li])
        h = _modulate(_rmsnorm(x, g_pre_ffn[li]), sh_f, sc_f)
        x = x + gt_f * _rmsnorm(_swiglu(h, w_ffn_in[li], w_ffn_out[li]), g_post_ffn[li])
    return x


def setup_inputs(seed: int = 0) -> dict:
    key = jax.random.key(seed)
    ks = jax.random.split(key, 32)
    nrm = jax.random.normal
    D, F = D_MODEL, FFN_HIDDEN
    NA, NS, G, P, GC = N_ATTN_LAYERS, N_SSM_LAYERS, S5_GROUPS, S5_STATE, S5_GROUP
    a_im_base = jnp.pi * jnp.arange(P, dtype=jnp.float32)
    return {
        "x_prompt": nrm(ks[0], (BATCH, SEQ, D), jnp.float32),
        "x_sample": nrm(ks[1], (DEC_BATCH, DEC_SEQ, D), jnp.float32),
        "c_prompt": nrm(ks[2], (BATCH, D), jnp.float32),
        "c_sample": nrm(ks[3], (DEC_BATCH, D), jnp.float32),
        "w_ada": nrm(ks[4], (DEPTH, D, 6 * D), jnp.float32) * (0.5 * D ** -0.5),
        "b_ada": nrm(ks[5], (DEPTH, 6 * D), jnp.float32) * 0.01,
        "g_pre_mix": 1.0 + 0.05 * nrm(ks[6], (DEPTH, D), jnp.float32),
        "g_post_mix": 1.0 + 0.05 * nrm(ks[7], (DEPTH, D), jnp.float32),
        "g_pre_ffn": 1.0 + 0.05 * nrm(ks[8], (DEPTH, D), jnp.float32),
        "g_post_ffn": 1.0 + 0.05 * nrm(ks[9], (DEPTH, D), jnp.float32),
        "w_ffn_in": nrm(ks[10], (DEPTH, D, 2 * F), jnp.float32) * D ** -0.5,
        "w_ffn_out": nrm(ks[11], (DEPTH, F, D), jnp.float32) * F ** -0.5,
        "w_attn_in": nrm(ks[12], (NA, D, IN_PROJ_WIDTH), jnp.float32) * D ** -0.5,
        "w_attn_out": nrm(ks[13], (NA, NA_WIDTH + DIFF_WIDTH, D), jnp.float32) * D ** -0.5,
        "na_rpb": 0.1 * nrm(ks[14], (NA, NA_HEADS, 2 * NA_MAX_WR - 1, 2 * NA_WC - 1), jnp.float32),
        "diff_lambda": 0.1 * nrm(ks[15], (NA, 4, DIFF_HEAD_DIM), jnp.float32),
        "diff_subln": 1.0 + 0.05 * nrm(ks[16], (NA, 2 * DIFF_HEAD_DIM), jnp.float32),
        "s5_a_re": -0.5 + 0.01 * nrm(ks[17], (NS, 2, G, P), jnp.float32),
        "s5_a_im": a_im_base + 0.01 * nrm(ks[18], (NS, 2, G, P), jnp.float32),
        "s5_log_dt": jax.random.uniform(ks[19], (NS, 2, G), jnp.float32,
                                        minval=math.log(1e-3), maxval=math.log(1e-1)),
        "s5_b_re": nrm(ks[20], (NS, 2, G, P, GC), jnp.float32) * (2.0 * GC) ** -0.5,
        "s5_b_im": nrm(ks[21], (NS, 2, G, P, GC), jnp.float32) * (2.0 * GC) ** -0.5,
        "s5_c_re": nrm(ks[22], (NS, 2, G, GC, P), jnp.float32) * (2.0 * P) ** -0.5,
        "s5_c_im": nrm(ks[23], (NS, 2, G, GC, P), jnp.float32) * (2.0 * P) ** -0.5,
        "s5_d": 0.5 * nrm(ks[24], (NS, D), jnp.float32),
        "s5_w_glu": nrm(ks[25], (NS, D, 2 * D), jnp.float32) * D ** -0.5,
    }


def reference(x_prompt, x_sample, c_prompt, c_sample, w_ada, b_ada, g_pre_mix, g_post_mix,
              g_pre_ffn, g_post_ffn, w_ffn_in, w_ffn_out, w_attn_in, w_attn_out, na_rpb,
              diff_lambda, diff_subln, s5_a_re, s5_a_im, s5_log_dt, s5_b_re, s5_b_im,
              s5_c_re, s5_c_im, s5_d, s5_w_glu):
    y_prompt = _trunk(x_prompt, c_prompt, w_ada, b_ada, g_pre_mix, g_post_mix, g_pre_ffn, g_post_ffn,
                      w_ffn_in, w_ffn_out, w_attn_in, w_attn_out, na_rpb, diff_lambda, diff_subln,
                      s5_a_re, s5_a_im, s5_log_dt, s5_b_re, s5_b_im, s5_c_re, s5_c_im, s5_d, s5_w_glu)
    y_sample = _trunk(x_sample, c_sample, w_ada, b_ada, g_pre_mix, g_post_mix, g_pre_ffn, g_post_ffn,
                      w_ffn_in, w_ffn_out, w_attn_in, w_attn_out, na_rpb, diff_lambda, diff_subln,
                      s5_a_re, s5_a_im, s5_log_dt, s5_b_re, s5_b_im, s5_c_re, s5_c_im, s5_d, s5_w_glu)
    return (y_prompt, y_sample)
```

```cpp
#ifndef ATT16
#define ATT16 1
#endif
#include <hip/hip_runtime.h>
#include <cstdio>
#include <cstdint>
namespace pg8 {
#define PG8_LAS __attribute__((address_space(3)))
typedef unsigned short bf16_t;
typedef short bf16x8 __attribute__((ext_vector_type(8)));
typedef float f32x4 __attribute__((ext_vector_type(4)));
typedef unsigned u32x4 __attribute__((ext_vector_type(4)));
constexpr int BM = 256, BK = 64, HALF = 128, HTB = HALF * BK * 2  , STAGE_BYTES = 8 * HTB, NXCD = 8, WGM = 8;

__host__ __device__ __forceinline__ int lds_byte(int r, int c) { const int st = (r >> 4) * 2 + (c >> 5), rr = r & 15, cc = c & 31, ob = rr * 64 + cc * 2; return st * 1024 + (ob ^ (((ob >> 9) & 1) << 5)); }
__host__ __device__ __forceinline__ void stage_rc(int b, int& R, int& C) { const int st = b / 1024, sb = b % 1024, swz = sb ^ (((sb >> 9) & 1) << 5); R = (st >> 1) * 16 + swz / 64; C = (st & 1) * 32 + (swz % 64) / 2; }
__host__ __device__ __forceinline__ int perm32(int rho) { const int n = rho >> 4, i = rho & 15; return 8 * (i >> 2) + 4 * n + (i & 3); }

struct Unit { int pm, pn; };
struct Gemm { const bf16_t* A; const bf16_t* Bt; int M, N, K; };

struct StaticOrder {
    int nM, nN, nwg, G, c;
    __host__ __device__ void init(int M, int N, int G_, int c_) { nM = M / BM; nN = N / BM; nwg = nM * nN; G = G_; c = c_; }
    __host__ __device__ bool next(int i, Unit& u) const {
        const long L = (long)i * G + c; if (L >= nwg) return false;
        int wgid = (int)L; { const int q = nwg / NXCD, r = nwg % NXCD, xcd = wgid % NXCD, off = wgid / NXCD; wgid = (xcd < r ? xcd * (q + 1) : r * (q + 1) + (xcd - r) * q) + off; }
        const int nig = WGM * nN, gid = wgid / nig, fm = gid * WGM, gsz = (nM - fm) < WGM ? (nM - fm) : WGM;
        u.pm = fm + ((wgid % nig) % gsz); u.pn = (wgid % nig) / gsz; return true;
    }
    __device__ __forceinline__ void a_ready(const Unit&) const {}
    __device__ __forceinline__ void done(const Unit&) const {}
};

__device__ __forceinline__ unsigned cvt_pk_bf16(float lo, float hi) { typedef __bf16 bfx2_ __attribute__((ext_vector_type(2))); typedef float flx2_ __attribute__((ext_vector_type(2))); const flx2_ v_ = {lo, hi}; return __builtin_bit_cast(unsigned, __builtin_convertvector(v_, bfx2_)); }

template <bool WT> __device__ __forceinline__ void st16(bf16_t* base, size_t elem_off, u32x4 w) {
    if constexpr (WT) { const __amdgpu_buffer_rsrc_t rs = __builtin_amdgcn_make_buffer_rsrc((void*)base, (short)0, 0x7ffffffe, 0x00020000); __builtin_amdgcn_raw_buffer_store_b128(w, rs, (unsigned)(elem_off * 2), 0, 16); }
    else *(u32x4*)(base + elem_off) = w;
}
template <bool WT = false> struct EpiPlain {
    static constexpr bool PERM = true, AFTER_DRAIN = false;
    bf16_t* O; int ldc;
    __device__ __forceinline__ void operator()(const f32x4 (&acc)[2][2][4][2], const Unit& u, int wr, int wc, int fr, int fq) const {
        const int row0 = u.pm * BM + wr * 64 + fr, col0 = u.pn * BM + wc * 32 + 8 * fq;
#pragma unroll
        for (int ai = 0; ai < 2; ++ai)
#pragma unroll
            for (int m = 0; m < 4; ++m) { const size_t ro = (size_t)(row0 + ai * HALF + m * 16) * ldc + col0;
#pragma unroll
                for (int bj = 0; bj < 2; ++bj) { const f32x4 v0 = acc[ai][bj][m][0], v1 = acc[ai][bj][m][1];
                    u32x4 w; w.x = cvt_pk_bf16(v0[0], v0[1]); w.y = cvt_pk_bf16(v0[2], v0[3]); w.z = cvt_pk_bf16(v1[0], v1[1]); w.w = cvt_pk_bf16(v1[2], v1[3]);
                    st16<WT>(O, ro + bj * HALF, w); } }
    }
};
__device__ __forceinline__ float sigm(float x) { return __builtin_amdgcn_rcpf(1.0f + __builtin_amdgcn_exp2f(-1.4426950408889634f * x)); }
template <int ACT, bool WT = false> struct EpiGated {
    static constexpr bool PERM = true, AFTER_DRAIN = false;
    bf16_t* O; int ldc;
    __device__ __forceinline__ float f(float a, float b) const { return ACT == 0 ? a * sigm(a) * b : a * sigm(b); }
    __device__ __forceinline__ void operator()(const f32x4 (&acc)[2][2][4][2], const Unit& u, int wr, int wc, int fr, int fq) const {
        const int row0 = u.pm * BM + wr * 64 + fr, col0 = u.pn * HALF + wc * 32 + 8 * fq;
#pragma unroll
        for (int ai = 0; ai < 2; ++ai)
#pragma unroll
            for (int m = 0; m < 4; ++m) { const size_t ro = (size_t)(row0 + ai * HALF + m * 16) * ldc + col0;
                const f32x4 a0 = acc[ai][0][m][0], a1 = acc[ai][0][m][1], b0 = acc[ai][1][m][0], b1 = acc[ai][1][m][1];
                u32x4 w; w.x = cvt_pk_bf16(f(a0[0], b0[0]), f(a0[1], b0[1])); w.y = cvt_pk_bf16(f(a0[2], b0[2]), f(a0[3], b0[3]));
                w.z = cvt_pk_bf16(f(a1[0], b1[0]), f(a1[1], b1[1])); w.w = cvt_pk_bf16(f(a1[2], b1[2]), f(a1[3], b1[3]));
                st16<WT>(O, ro, w); }
    }
};

template <class Epi, class Sched, bool ALIGN_EPI = false, bool SP2 = false>
__device__ __forceinline__ void gemm_phase(PG8_LAS unsigned char* lds, const Gemm g, const Sched& S, const Epi& E, const int tid_in) {
    const int tid = tid_in, wid = __builtin_amdgcn_readfirstlane(tid >> 6), lane = tid & 63, wr = wid >> 2, wc = wid & 3, fr = lane & 15, fq = lane >> 4;
    const int K = g.K, nt = K / BK;
    unsigned voffA[2], voffB[2];
#pragma unroll
    for (int i = 0; i < 2; ++i) { int R, C; stage_rc(tid * 16 + i * 8192, R, C); const int Rb = Epi::PERM ? ((R & ~31) + perm32(R & 31)) : R;
        voffA[i] = (unsigned)(R * K + C) * 2u; voffB[i] = (unsigned)(Rb * K + C) * 2u; }
    const size_t kstep = (size_t)(BK * 2);
    const size_t hstep = (size_t)HALF * K * 2;
    const size_t tstep = 2 * hstep;
    const unsigned ldsw = (unsigned)wid * 1024u;
    const int aoff = lds_byte(wr * 64 + fr, fq * 8), boff = lds_byte(wc * 32 + fr, fq * 8);
#define PG8_SA(b, h) (((b) * 2 + (h)) * HTB)
#define PG8_SB(b, h) ((4 + (b) * 2 + (h)) * HTB)
#define PG8_STAGE(bufoff, gbase, voff) do { _Pragma("unroll") for (int _i = 0; _i < 2; ++_i) \
        __builtin_amdgcn_global_load_lds((const unsigned*)((const char*)(gbase) + (voff)[_i]), (PG8_LAS unsigned*)(lds + (bufoff) + ldsw + _i * 8192), 16, 0, 0); } while (0)
#define PG8_LDA(dst, b, h) do { _Pragma("unroll") for (int m = 0; m < 4; ++m) _Pragma("unroll") for (int k = 0; k < 2; ++k) dst[m][k] = *(const PG8_LAS bf16x8*)(lds + PG8_SA(b, h) + aoff + m * 2048 + k * 1024); } while (0)
#define PG8_LDB(dst, b, h) do { _Pragma("unroll") for (int n = 0; n < 2; ++n) _Pragma("unroll") for (int k = 0; k < 2; ++k) dst[n][k] = *(const PG8_LAS bf16x8*)(lds + PG8_SB(b, h) + boff + n * 2048 + k * 1024); } while (0)
#define PG8_MMA(ai, bj, At, Bt) do { __builtin_amdgcn_s_setprio(1); _Pragma("unroll") for (int m = 0; m < 4; ++m) _Pragma("unroll") for (int n = 0; n < 2; ++n) _Pragma("unroll") for (int k = 0; k < 2; ++k) \
        acc[ai][bj][m][n] = __builtin_amdgcn_mfma_f32_16x16x32_bf16(Bt[n][k], At[m][k], acc[ai][bj][m][n], 0, 0, 0); __builtin_amdgcn_s_setprio(0); } while (0)
#define PG8_WAIT_V(n) asm volatile("s_waitcnt vmcnt(" #n ")" ::: "memory")
#define PG8_WAIT_L(n) asm volatile("s_waitcnt lgkmcnt(" #n ")" ::: "memory")
#define PG8_BAR __builtin_amdgcn_s_barrier()
#define PG8_SCHED __builtin_amdgcn_sched_barrier(0)
    Unit cur, nxt; int ui = 0;
    if (!S.next(0, cur)) return;
    f32x4 acc[2][2][4][2];
#pragma unroll
    for (int a = 0; a < 2; ++a)
#pragma unroll
        for (int b = 0; b < 2; ++b)
#pragma unroll
            for (int m = 0; m < 4; ++m)
#pragma unroll
                for (int n = 0; n < 2; ++n) acc[a][b][m][n] = (f32x4){0.f, 0.f, 0.f, 0.f};
    bf16x8 At[4][2], B0[2][2], B1[2][2];
    const char* cA = (const char*)g.A + (size_t)cur.pm * tstep; const char* cB = (const char*)g.Bt + (size_t)cur.pn * tstep;
    S.a_ready(cur);
    if constexpr (SP2) {
        PG8_STAGE(PG8_SB(0, 0), cB, voffB); PG8_STAGE(PG8_SB(0, 1), cB + hstep, voffB); PG8_STAGE(PG8_SA(0, 0), cA, voffA); PG8_STAGE(PG8_SA(0, 1), cA + hstep, voffA);
        if (wr == 1) PG8_BAR;
        PG8_WAIT_V(2); PG8_BAR;
        PG8_STAGE(PG8_SB(1, 0), cB + kstep, voffB); PG8_STAGE(PG8_SA(1, 0), cA + kstep, voffA); PG8_STAGE(PG8_SB(1, 1), cB + hstep + kstep, voffB);
        PG8_WAIT_V(6); PG8_BAR;
    } else {
        PG8_STAGE(PG8_SB(0, 0), cB, voffB); PG8_STAGE(PG8_SA(0, 0), cA, voffA); PG8_STAGE(PG8_SB(0, 1), cB + hstep, voffB); PG8_STAGE(PG8_SA(0, 1), cA + hstep, voffA);
        if (wr == 1) PG8_BAR;
        PG8_WAIT_V(4); PG8_BAR;
        PG8_STAGE(PG8_SB(1, 0), cB + kstep, voffB); PG8_STAGE(PG8_SA(1, 0), cA + kstep, voffA); PG8_STAGE(PG8_SB(1, 1), cB + hstep + kstep, voffB);
        PG8_WAIT_V(6); PG8_BAR;
    }
    for (;;) {
        const bool has_next = S.next(ui + 1, nxt);
        const char* nA = has_next ? (const char*)g.A + (size_t)nxt.pm * tstep : cA; const char* nB = has_next ? (const char*)g.Bt + (size_t)nxt.pn * tstep : cB;
        for (int t = 0; t < nt; t += 2) {
            const bool last = (t == nt - 2);
            const char* a1 = cA + (size_t)(t + 1) * kstep;
            const char* a2 = last ? nA : cA + (size_t)(t + 2) * kstep; const char* b2 = last ? nB : cB + (size_t)(t + 2) * kstep;
            const char* a3 = a2 + kstep; const char* b3 = b2 + kstep;
            if (last && has_next) S.a_ready(nxt);
            if constexpr (SP2) {
            PG8_LDB(B0, 0, 0); PG8_LDB(B1, 0, 1); PG8_SCHED; PG8_LDA(At, 0, 0); PG8_STAGE(PG8_SA(1, 1), a1 + hstep, voffA);
            PG8_WAIT_V(8); PG8_WAIT_L(0); PG8_BAR; PG8_MMA(0, 0, At, B0); PG8_MMA(0, 1, At, B1); PG8_BAR; PG8_SCHED;
            PG8_LDA(At, 0, 1); PG8_STAGE(PG8_SB(0, 0), b2, voffB); PG8_STAGE(PG8_SB(0, 1), b2 + hstep, voffB); PG8_STAGE(PG8_SA(0, 0), a2, voffA);
            PG8_WAIT_V(8); PG8_WAIT_L(0); PG8_BAR; PG8_MMA(1, 0, At, B0); PG8_MMA(1, 1, At, B1); PG8_BAR; PG8_SCHED;
            PG8_LDB(B0, 1, 0); PG8_LDB(B1, 1, 1); PG8_SCHED; PG8_LDA(At, 1, 0); PG8_STAGE(PG8_SA(0, 1), a2 + hstep, voffA);
            PG8_WAIT_V(8); PG8_WAIT_L(0); PG8_BAR; PG8_MMA(0, 0, At, B0); PG8_MMA(0, 1, At, B1); PG8_BAR; PG8_SCHED;
            PG8_LDA(At, 1, 1); PG8_STAGE(PG8_SB(1, 0), b3, voffB); PG8_STAGE(PG8_SB(1, 1), b3 + hstep, voffB); PG8_STAGE(PG8_SA(1, 0), a3, voffA);
            PG8_WAIT_V(8); PG8_WAIT_L(0); PG8_BAR; PG8_MMA(1, 0, At, B0); PG8_MMA(1, 1, At, B1); PG8_BAR; PG8_SCHED;
            } else {
            PG8_LDB(B0, 0, 0); PG8_SCHED; PG8_LDA(At, 0, 0); PG8_STAGE(PG8_SA(1, 1), a1 + hstep, voffA);
            PG8_WAIT_L(8); PG8_BAR; PG8_WAIT_L(0); PG8_MMA(0, 0, At, B0); PG8_BAR; PG8_SCHED;
            PG8_LDB(B1, 0, 1); PG8_STAGE(PG8_SB(0, 0), b2, voffB);
            PG8_BAR; PG8_WAIT_L(0); PG8_MMA(0, 1, At, B1); PG8_BAR;
            PG8_LDA(At, 0, 1); PG8_STAGE(PG8_SA(0, 0), a2, voffA);
            PG8_BAR; PG8_WAIT_L(0); PG8_MMA(1, 0, At, B0); PG8_BAR; PG8_SCHED;
            PG8_STAGE(PG8_SB(0, 1), b2 + hstep, voffB);
            PG8_WAIT_V(6); PG8_BAR; PG8_MMA(1, 1, At, B1); PG8_BAR;
            PG8_LDB(B0, 1, 0); PG8_SCHED; PG8_LDA(At, 1, 0); PG8_STAGE(PG8_SA(0, 1), a2 + hstep, voffA);
            PG8_WAIT_L(8); PG8_BAR; PG8_WAIT_L(0); PG8_MMA(0, 0, At, B0); PG8_BAR; PG8_SCHED;
            PG8_LDB(B1, 1, 1); PG8_STAGE(PG8_SB(1, 0), b3, voffB);
            PG8_BAR; PG8_WAIT_L(0); PG8_MMA(0, 1, At, B1); PG8_BAR;
            PG8_LDA(At, 1, 1); PG8_STAGE(PG8_SA(1, 0), a3, voffA);
            PG8_BAR; PG8_WAIT_L(0); PG8_MMA(1, 0, At, B0); PG8_BAR; PG8_SCHED;
            PG8_STAGE(PG8_SB(1, 1), b3 + hstep, voffB);
            PG8_WAIT_V(6); PG8_BAR; PG8_MMA(1, 1, At, B1); PG8_BAR;
            }
        }
        if constexpr (ALIGN_EPI) { if (wr == 0) PG8_BAR; }
        if constexpr (!Epi::AFTER_DRAIN) { E(acc, cur, wr, wc, fr, fq); S.done(cur); }
        if (!has_next) break;
#pragma unroll
        for (int a = 0; a < 2; ++a)
#pragma unroll
            for (int b = 0; b < 2; ++b)
#pragma unroll
                for (int m = 0; m < 4; ++m)
#pragma unroll
                    for (int n = 0; n < 2; ++n) acc[a][b][m][n] = (f32x4){0.f, 0.f, 0.f, 0.f};
        cur = nxt; cA = nA; cB = nB; ++ui;
        if constexpr (ALIGN_EPI) { if (wr == 1) PG8_BAR; }
    }
    PG8_WAIT_V(0);
    if constexpr (!ALIGN_EPI) { if (wr == 0) PG8_BAR; }
    PG8_BAR;
    if constexpr (Epi::AFTER_DRAIN) { E.fused(acc, cur, wr, wc, fr, fq, lds, wid, lane); S.done(cur); }
#undef PG8_SA
#undef PG8_SB
#undef PG8_STAGE
#undef PG8_LDA
#undef PG8_LDB
#undef PG8_MMA
#undef PG8_WAIT_V
#undef PG8_WAIT_L
#undef PG8_BAR
#undef PG8_SCHED
}
}

#define LAS __attribute__((address_space(3)))

namespace at {
typedef unsigned short bf16;
constexpr int   D = 128, NW = 8, QBLK = 32, KVBLK = 64;
constexpr float SCALE = 0.088388347648318440f;
constexpr float THR = 8.f;
constexpr int   LDX = 6144;
constexpr size_t SHM_V = KVBLK * D * 2, SHM_K = KVBLK * D * 2, SHM_ATTN = 2 * SHM_V + 2 * SHM_K + NW * 64 * 4;
constexpr size_t SHM_RPB = SHM_ATTN;
using bf16x8 = __attribute__((ext_vector_type(8))) short;
using s16x4  = __attribute__((ext_vector_type(4))) short;
using f32x16 = __attribute__((ext_vector_type(16))) float;
using u32x4  = __attribute__((ext_vector_type(4))) unsigned;
#define KSWZ(row, colB) ((row) * 256 + ((colB) ^ (((row) & 7) << 4)))
#define SBAR() __builtin_amdgcn_sched_barrier(0)
__device__ __forceinline__ int crow(int r, int hi) { return (r & 3) + 8 * (r >> 2) + 4 * hi; }
__device__ __forceinline__ unsigned cvtpk(float lo, float hi) { typedef __bf16 bfx2_ __attribute__((ext_vector_type(2))); typedef float flx2_ __attribute__((ext_vector_type(2))); const flx2_ v_ = {lo, hi}; return __builtin_bit_cast(unsigned, __builtin_convertvector(v_, bfx2_)); }
__device__ __forceinline__ bf16x8 ld8(const bf16* p) { return *reinterpret_cast<const bf16x8*>(p); }

template <int OFF> __device__ __forceinline__ bf16x8 k_read(int a) { bf16x8 r; asm volatile("ds_read_b128 %0, %1 offset:%2" : "=&v"(r) : "v"(a), "i"(OFF) : "memory"); return r; }
__device__ __forceinline__ void qkt_pipe(f32x16& p0, f32x16& p1, int kaddr, int sw, int h16, const bf16x8* qr) {
  p0 = f32x16{}; p1 = f32x16{};
  bf16x8 a0, a1, b0, b1;
#define KAD(d) (kaddr + ((((d) * 32) + h16) ^ sw))
  { const int ad = KAD(0); a0 = k_read<0>(ad); a1 = k_read<8192>(ad); }
#define QK_STEP(d, C0, C1, N0, N1) do { { const int ad = KAD((d) + 1); N0 = k_read<0>(ad); N1 = k_read<8192>(ad); } asm volatile("s_waitcnt lgkmcnt(2)" ::: "memory"); SBAR(); \
    p0 = __builtin_amdgcn_mfma_f32_32x32x16_bf16(C0, qr[d], p0, 0, 0, 0); p1 = __builtin_amdgcn_mfma_f32_32x32x16_bf16(C1, qr[d], p1, 0, 0, 0); SBAR(); } while (0)
  QK_STEP(0, a0, a1, b0, b1); QK_STEP(1, b0, b1, a0, a1); QK_STEP(2, a0, a1, b0, b1); QK_STEP(3, b0, b1, a0, a1); QK_STEP(4, a0, a1, b0, b1); QK_STEP(5, b0, b1, a0, a1); QK_STEP(6, a0, a1, b0, b1);
  asm volatile("s_waitcnt lgkmcnt(0)" ::: "memory"); SBAR();
  p0 = __builtin_amdgcn_mfma_f32_32x32x16_bf16(b0, qr[7], p0, 0, 0, 0); p1 = __builtin_amdgcn_mfma_f32_32x32x16_bf16(b1, qr[7], p1, 0, 0, 0);
#undef QK_STEP
#undef KAD
}
__device__ __forceinline__ void partialSM(f32x16& p0, f32x16& p1, float& m_reg, float& mn, float& alpha) {
  constexpr float C = SCALE * 1.4426950408889634f;
  float pmax;
  { float c0 = fmaxf(p0[0], p0[1]), c1 = fmaxf(p0[8], p0[9]), c2 = fmaxf(p1[0], p1[1]), c3 = fmaxf(p1[8], p1[9]);
#pragma unroll
    for (int r = 2; r < 8; r += 2) { c0 = fmaxf(fmaxf(c0, p0[r]), p0[r + 1]); c1 = fmaxf(fmaxf(c1, p0[8 + r]), p0[9 + r]); c2 = fmaxf(fmaxf(c2, p1[r]), p1[r + 1]); c3 = fmaxf(fmaxf(c3, p1[8 + r]), p1[9 + r]); }
    pmax = fmaxf(fmaxf(c0, c1), fmaxf(c2, c3)); }
  { auto rr = __builtin_amdgcn_permlane32_swap(__float_as_uint(pmax), __float_as_uint(pmax), false, false);
    pmax = fmaxf(__uint_as_float(rr[0]), __uint_as_float(rr[1])); }
  if (__builtin_expect(__all(pmax - m_reg <= THR / SCALE), 1)) { mn = m_reg; alpha = 1.f; }
  else { mn = fmaxf(m_reg, pmax); alpha = __builtin_amdgcn_exp2f((m_reg - mn) * C); m_reg = mn; }
  float mnC = -mn * C;
#pragma unroll
  for (int r = 0; r < 16; ++r) p0[r] = fmaf(p0[r], C, mnC);
#pragma unroll
  for (int r = 0; r < 16; ++r) p1[r] = fmaf(p1[r], C, mnC);
#pragma unroll
  for (int r = 0; r < 16; ++r) p0[r] = __builtin_amdgcn_exp2f(p0[r]);
}
__device__ __forceinline__ void partialSM2(f32x16& p0, const f32x16& p1, float& m_reg, float& alpha, float& mnC) {
  constexpr float C = SCALE * 1.4426950408889634f;
  float pmax;
  { float c0 = fmaxf(p0[0], p0[1]), c1 = fmaxf(p0[8], p0[9]), c2 = fmaxf(p1[0], p1[1]), c3 = fmaxf(p1[8], p1[9]);
#pragma unroll
    for (int r = 2; r < 8; r += 2) { c0 = fmaxf(fmaxf(c0, p0[r]), p0[r + 1]); c1 = fmaxf(fmaxf(c1, p0[8 + r]), p0[9 + r]); c2 = fmaxf(fmaxf(c2, p1[r]), p1[r + 1]); c3 = fmaxf(fmaxf(c3, p1[8 + r]), p1[9 + r]); }
    pmax = fmaxf(fmaxf(c0, c1), fmaxf(c2, c3)); }
  { auto rr = __builtin_amdgcn_permlane32_swap(__float_as_uint(pmax), __float_as_uint(pmax), false, false);
    pmax = fmaxf(__uint_as_float(rr[0]), __uint_as_float(rr[1])); }
  float mn;
  if (__builtin_expect(__all(pmax - m_reg <= THR / SCALE), 1)) { mn = m_reg; alpha = 1.f; }
  else { mn = fmaxf(m_reg, pmax); alpha = __builtin_amdgcn_exp2f((m_reg - mn) * C); m_reg = mn; }
  mnC = -mn * C;
#pragma unroll
  for (int r = 0; r < 16; ++r) p0[r] = __builtin_amdgcn_exp2f(fmaf(p0[r], C, mnC));
}
__device__ __forceinline__ void finishSM(f32x16& p0, f32x16& p1, float alpha, float& l_reg, bf16x8& pa0, bf16x8& pa1, bf16x8& pa2, bf16x8& pa3) {
#pragma unroll
  for (int r = 0; r < 16; ++r) p1[r] = __builtin_amdgcn_exp2f(p1[r]);
  float ps = 0;
#pragma unroll
  for (int r = 0; r < 16; ++r) ps += p0[r];
#pragma unroll
  for (int r = 0; r < 16; ++r) ps += p1[r];
  { auto rr = __builtin_amdgcn_permlane32_swap(__float_as_uint(ps), __float_as_uint(ps), false, false);
    ps = __uint_as_float(rr[0]) + __uint_as_float(rr[1]); }
  l_reg = l_reg * alpha + ps;
#define PK4(P, BASE, OUT) do { unsigned a0 = cvtpk(P[BASE + 0], P[BASE + 1]), a1 = cvtpk(P[BASE + 2], P[BASE + 3]);   \
    unsigned b0 = cvtpk(P[BASE + 4], P[BASE + 5]), b1 = cvtpk(P[BASE + 6], P[BASE + 7]);                              \
    auto r0 = __builtin_amdgcn_permlane32_swap(a0, b0, false, false); auto r1 = __builtin_amdgcn_permlane32_swap(a1, b1, false, false); \
    u32x4 w = {r0[0], r1[0], r0[1], r1[1]}; OUT = __builtin_bit_cast(bf16x8, w); } while (0)
  PK4(p0, 0, pa0); PK4(p0, 8, pa1); PK4(p1, 0, pa2); PK4(p1, 8, pa3);
#undef PK4
}
__device__ __forceinline__ void qkt(f32x16& p0, f32x16& p1, const bf16* Ks, const bf16x8* qr, int r32, int hi) {
  p0 = f32x16{}; p1 = f32x16{};
#pragma unroll
  for (int d0 = 0; d0 < 8; ++d0) { int cb = (d0 * 16 + hi * 8) * 2;
    bf16x8 b0 = *reinterpret_cast<const bf16x8*>((const char*)Ks + KSWZ(r32, cb));
    bf16x8 b1 = *reinterpret_cast<const bf16x8*>((const char*)Ks + KSWZ(32 + r32, cb));
    p0 = __builtin_amdgcn_mfma_f32_32x32x16_bf16(b0, qr[d0], p0, 0, 0, 0);
    p1 = __builtin_amdgcn_mfma_f32_32x32x16_bf16(b1, qr[d0], p1, 0, 0, 0); }
}
__device__ __forceinline__ int v_st(int k, int c) { const int kk = (k & ~0xC) | ((k & 4) << 1) | ((k & 8) >> 1); return ((kk >> 3) * 4 + (c >> 5)) * 512 + ((kk & 7) * 32 + (c & 31)) * 2; }
__device__ __forceinline__ int v_rd_base(int lane) { return ((lane & 3) << 3) | (((lane >> 2) & 3) << 6) | (((lane >> 4) & 1) << 5) | (((lane >> 5) & 1) << 8); }
constexpr int v_rd_off(int d0, int ks, int half) { return d0 * 512 + ks * 4096 + half * 2048; }
template <int OFF> __device__ __forceinline__ s16x4 tr_read(int vb) {
  s16x4 r; asm volatile("ds_read_b64_tr_b16 %0, %1 offset:%2" : "=&v"(r) : "v"(vb), "i"(OFF) : "memory"); return r;
}
template <int D0> __device__ __forceinline__ void pv_one(f32x16& od, int vb, bf16x8 pa0, bf16x8 pa1, bf16x8 pa2, bf16x8 pa3) {
  const s16x4 l0 = tr_read<v_rd_off(D0, 0, 0)>(vb), h0 = tr_read<v_rd_off(D0, 0, 1)>(vb), l1 = tr_read<v_rd_off(D0, 1, 0)>(vb), h1 = tr_read<v_rd_off(D0, 1, 1)>(vb);
  const s16x4 l2 = tr_read<v_rd_off(D0, 2, 0)>(vb), h2 = tr_read<v_rd_off(D0, 2, 1)>(vb), l3 = tr_read<v_rd_off(D0, 3, 0)>(vb), h3 = tr_read<v_rd_off(D0, 3, 1)>(vb);
  asm volatile("s_waitcnt lgkmcnt(0)" ::: "memory"); SBAR();
#define PK(L, H) (bf16x8){L[0], L[1], L[2], L[3], H[0], H[1], H[2], H[3]}
  od = __builtin_amdgcn_mfma_f32_32x32x16_bf16(pa0, PK(l0, h0), od, 0, 0, 0);
  od = __builtin_amdgcn_mfma_f32_32x32x16_bf16(pa1, PK(l1, h1), od, 0, 0, 0);
  od = __builtin_amdgcn_mfma_f32_32x32x16_bf16(pa2, PK(l2, h2), od, 0, 0, 0);
  od = __builtin_amdgcn_mfma_f32_32x32x16_bf16(pa3, PK(l3, h3), od, 0, 0, 0);
#undef PK
}
__device__ __forceinline__ void pv_d0(f32x16* o, int vb, bf16x8 pa0, bf16x8 pa1, bf16x8 pa2, bf16x8 pa3) {
  pv_one<0>(o[0], vb, pa0, pa1, pa2, pa3); pv_one<1>(o[1], vb, pa0, pa1, pa2, pa3); pv_one<2>(o[2], vb, pa0, pa1, pa2, pa3); pv_one<3>(o[3], vb, pa0, pa1, pa2, pa3);
}

__device__ __forceinline__ void flash_pass(const bf16* __restrict__ Qb, const bf16* __restrict__ Kh, const bf16* __restrict__ Vh, int seq, char* lds, f32x16 (&o)[4], float& l_out, const int tid) {
  const int wid = tid >> 6, lane = tid & 63, r32 = lane & 31, hi = lane >> 5;
  bf16* V_lds = (bf16*)lds; bf16* K_lds = (bf16*)(lds + 2 * SHM_V);
  float* ws = (float*)(lds + 2 * SHM_V + 2 * SHM_K) + wid * 64; float* al_l = ws + 32;
  float m_reg = -1e30f, l_reg = 0; bf16x8 qr[8];
#pragma unroll
  for (int d = 0; d < 4; ++d) o[d] = f32x16{};
  const bf16* Qw = Qb + (long)(wid * QBLK + r32) * LDX + hi * 8;
#pragma unroll
  for (int d0 = 0; d0 < 8; ++d0) qr[d0] = ld8(Qw + d0 * 16);
  const int sr = tid >> 4, sc = (tid & 15) * 8, vst0 = v_st(sr, sc), vst1 = v_st(32 + sr, sc);
  const int vb0 = (int)(uintptr_t)V_lds + v_rd_base(lane);
  struct { bf16x8 vs0, vs1, ks0, ks1; } sr_[1];
  const unsigned vo0 = (unsigned)(sr * LDX + sc) * 2u;
  const __amdgpu_buffer_rsrc_t rsK = __builtin_amdgcn_make_buffer_rsrc((void*)Kh, (short)0, seq * (LDX * 2), 0x00020000), rsV = __builtin_amdgcn_make_buffer_rsrc((void*)Vh, (short)0, seq * (LDX * 2), 0x00020000);
#define BLD(rs, vo, so) __builtin_bit_cast(bf16x8, __builtin_amdgcn_raw_buffer_load_b128(rs, vo, so, 0))
#define SLOAD(i, k0) do { const unsigned so_ = (unsigned)(k0) * (unsigned)(LDX * 2); \
    sr_[i].vs0 = BLD(rsV, vo0, so_); sr_[i].vs1 = BLD(rsV, vo0, so_ + 32u * LDX * 2u); sr_[i].ks0 = BLD(rsK, vo0, so_); sr_[i].ks1 = BLD(rsK, vo0, so_ + 32u * LDX * 2u); } while (0)
#define SWRITE(b, i) do { *(bf16x8*)((char*)V_lds + (b) * SHM_V + vst0) = sr_[i].vs0;          \
    *(bf16x8*)((char*)V_lds + (b) * SHM_V + vst1) = sr_[i].vs1; int kc = sc * 2;               \
    *(bf16x8*)((char*)K_lds + (b) * SHM_K + KSWZ(sr, kc)) = sr_[i].ks0;                       \
    *(bf16x8*)((char*)K_lds + (b) * SHM_K + KSWZ(32 + sr, kc)) = sr_[i].ks1; } while (0)
#define SWAIT() asm volatile("s_waitcnt vmcnt(0)" ::: "memory")
#define RESC(a) do { if (__any((a) < 1.f)) { if (hi == 0) al_l[r32] = (a); asm volatile("s_waitcnt lgkmcnt(0)" ::: "memory"); \
    _Pragma("unroll") for (int d = 0; d < 4; ++d) _Pragma("unroll") for (int r = 0; r < 16; ++r) o[d][r] *= al_l[crow(r, hi)]; } } while (0)
  f32x16 pA0, pA1, pB0, pB1; float mnA, mnB, alA, alB; bf16x8 pa0, pa1, pa2, pa3; const int NT = seq / KVBLK;
  constexpr int SE = 0, SO = 0;
  SLOAD(SE, 0); asm volatile("s_waitcnt vmcnt(0)" ::: "memory");
  __syncthreads();
  SWRITE(0, SE); __syncthreads();
  qkt(pA0, pA1, K_lds, qr, r32, hi); partialSM(pA0, pA1, m_reg, mnA, alA);
  SLOAD(SO, KVBLK);
  SWAIT(); SWRITE(1, SO); __syncthreads();
  for (int j = 1; j + 1 < NT; j += 2) {
    SBAR(); qkt(pB0, pB1, (bf16*)((char*)K_lds + SHM_K), qr, r32, hi);
    finishSM(pA0, pA1, alA, l_reg, pa0, pa1, pa2, pa3); SBAR();
    SLOAD(SO, (j + 1) * KVBLK); SBAR();
    pv_d0(o, vb0, pa0, pa1, pa2, pa3); partialSM(pB0, pB1, m_reg, mnB, alB);
    __syncthreads(); SWAIT(); SWRITE(0, SE);
    RESC(alB); __syncthreads();
    SBAR(); qkt(pA0, pA1, K_lds, qr, r32, hi);
    finishSM(pB0, pB1, alB, l_reg, pa0, pa1, pa2, pa3); SBAR();
    SLOAD(SE, (j + 2) * KVBLK); SBAR();
    pv_d0(o, vb0 + (int)SHM_V, pa0, pa1, pa2, pa3); partialSM(pA0, pA1, m_reg, mnA, alA);
    __syncthreads(); SWAIT(); SWRITE(1, SO);
    RESC(alA); __syncthreads();
  }
  SBAR(); qkt(pB0, pB1, (bf16*)((char*)K_lds + SHM_K), qr, r32, hi);
  finishSM(pA0, pA1, alA, l_reg, pa0, pa1, pa2, pa3); SBAR();
  pv_d0(o, vb0, pa0, pa1, pa2, pa3); partialSM(pB0, pB1, m_reg, mnB, alB);
  __syncthreads(); RESC(alB);
  finishSM(pB0, pB1, alB, l_reg, pa0, pa1, pa2, pa3); SBAR();
  pv_d0(o, vb0 + (int)SHM_V, pa0, pa1, pa2, pa3);
  l_out = l_reg;
#undef SLOAD
#undef SWAIT
}

__device__ __forceinline__ void diff_unit(const bf16* __restrict__ QKV, float* __restrict__ DIFFO, int rb, int T, int h, int qb, int half, float lam, char* lds, const int tid0) {
#pragma unroll 1
  for (int n = 0; n < 2; ++n) {
    { unsigned z = 0; asm volatile("" : "+s"(z)); QKV += z; }
    const bf16* Qb = QKV + (size_t)(rb + qb * 256) * LDX + 3072 + (h * 2 + n) * 128;
    const bf16* Kh = QKV + (size_t)rb * LDX + 4096 + (h * 2 + n) * 128;
    const bf16* Vh = QKV + (size_t)rb * LDX + 5120 + h * 256 + half * 128;
    f32x16 o[4]; float l_reg;
    flash_pass(Qb, Kh, Vh, T, lds, o, l_reg, tid0);
    int tid = tid0; asm volatile("" : "+v"(tid));
    const int wid = __builtin_amdgcn_readfirstlane(tid >> 6), lane = tid & 63, r32 = lane & 31, hi = lane >> 5;
    float* li_l = (float*)(lds + 2 * SHM_V + 2 * SHM_K) + wid * 64;
    float* Ow = DIFFO + (size_t)(rb + qb * 256 + wid * QBLK) * 1024 + h * 256 + half * 128 + r32;
    if (hi == 0) li_l[r32] = l_reg; asm volatile("s_waitcnt lgkmcnt(0)" ::: "memory");
    const float sgn = n ? -lam : 1.0f;
#pragma unroll
    for (int r = 0; r < 16; ++r) { const int orow = crow(r, hi); const float rl = __builtin_amdgcn_rcpf(li_l[orow]) * sgn;
#pragma unroll
      for (int d0 = 0; d0 < 4; ++d0) { float* p = Ow + (size_t)orow * 1024 + d0 * 32; float v = o[d0][r] * rl; if (n) v += *p; *p = v; } }
  }
}

struct TrFrag { s16x4 l0, h0, l1, h1, l2, h2, l3, h3; };
template <int G> __device__ __forceinline__ void tr_frag(TrFrag& f, int vb) {
  constexpr int B = (G >> 2) * 16384, D0 = G & 3;
  f.l0 = tr_read<B + v_rd_off(D0, 0, 0)>(vb); f.h0 = tr_read<B + v_rd_off(D0, 0, 1)>(vb); f.l1 = tr_read<B + v_rd_off(D0, 1, 0)>(vb); f.h1 = tr_read<B + v_rd_off(D0, 1, 1)>(vb);
  f.l2 = tr_read<B + v_rd_off(D0, 2, 0)>(vb); f.h2 = tr_read<B + v_rd_off(D0, 2, 1)>(vb); f.l3 = tr_read<B + v_rd_off(D0, 3, 0)>(vb); f.h3 = tr_read<B + v_rd_off(D0, 3, 1)>(vb);
}
__device__ __forceinline__ void pv_mma(f32x16& od, const TrFrag& f, bf16x8 pa0, bf16x8 pa1, bf16x8 pa2, bf16x8 pa3) {
#define PK(L, H) (bf16x8){L[0], L[1], L[2], L[3], H[0], H[1], H[2], H[3]}
  od = __builtin_amdgcn_mfma_f32_32x32x16_bf16(pa0, PK(f.l0, f.h0), od, 0, 0, 0);
  od = __builtin_amdgcn_mfma_f32_32x32x16_bf16(pa1, PK(f.l1, f.h1), od, 0, 0, 0);
  od = __builtin_amdgcn_mfma_f32_32x32x16_bf16(pa2, PK(f.l2, f.h2), od, 0, 0, 0);
  od = __builtin_amdgcn_mfma_f32_32x32x16_bf16(pa3, PK(f.l3, f.h3), od, 0, 0, 0);
#undef PK
}
#define PV_STEP(G, CUR, NXT) do { tr_frag<(G) + 1>(NXT, vb); asm volatile("s_waitcnt lgkmcnt(8)" ::: "memory"); SBAR(); pv_mma(o[G], CUR, pa0, pa1, pa2, pa3); SBAR(); } while (0)
__device__ __forceinline__ void pv_pipe(f32x16* o, int vb, bf16x8 pa0, bf16x8 pa1, bf16x8 pa2, bf16x8 pa3) {
  TrFrag fa, fb;
  tr_frag<0>(fa, vb);
  PV_STEP(0, fa, fb); PV_STEP(1, fb, fa); PV_STEP(2, fa, fb); PV_STEP(3, fb, fa); PV_STEP(4, fa, fb); PV_STEP(5, fb, fa); PV_STEP(6, fa, fb);
  asm volatile("s_waitcnt lgkmcnt(0)" ::: "memory"); SBAR(); pv_mma(o[7], fb, pa0, pa1, pa2, pa3);
}
__device__ __forceinline__ void pv_pipe4(f32x16* o, int vb, bf16x8 pa0, bf16x8 pa1, bf16x8 pa2, bf16x8 pa3) {
  TrFrag fa, fb;
  tr_frag<0>(fa, vb);
  PV_STEP(0, fa, fb); PV_STEP(1, fb, fa); PV_STEP(2, fa, fb);
  asm volatile("s_waitcnt lgkmcnt(0)" ::: "memory"); SBAR(); pv_mma(o[3], fb, pa0, pa1, pa2, pa3);
}
#undef PV_STEP

struct TrFrag2 { s16x4 la, ha, lb, hb; };
template <int G, int KH> __device__ __forceinline__ void tr_frag2(TrFrag2& f, int vb) {
  constexpr int B = (G >> 2) * 16384, D0 = G & 3;
  f.la = tr_read<B + v_rd_off(D0, 2 * KH, 0)>(vb); f.ha = tr_read<B + v_rd_off(D0, 2 * KH, 1)>(vb); f.lb = tr_read<B + v_rd_off(D0, 2 * KH + 1, 0)>(vb); f.hb = tr_read<B + v_rd_off(D0, 2 * KH + 1, 1)>(vb);
}
__device__ __forceinline__ void pv_mma2(f32x16& od, const TrFrag2& f, bf16x8 pX, bf16x8 pY) {
#define PK(L, H) (bf16x8){L[0], L[1], L[2], L[3], H[0], H[1], H[2], H[3]}
  od = __builtin_amdgcn_mfma_f32_32x32x16_bf16(pX, PK(f.la, f.ha), od, 0, 0, 0);
  od = __builtin_amdgcn_mfma_f32_32x32x16_bf16(pY, PK(f.lb, f.hb), od, 0, 0, 0);
#undef PK
}
#define PKH(P, BASE, OUT) do { unsigned a0_ = cvtpk(P[BASE + 0], P[BASE + 1]), a1_ = cvtpk(P[BASE + 2], P[BASE + 3]); unsigned b0_ = cvtpk(P[BASE + 4], P[BASE + 5]), b1_ = cvtpk(P[BASE + 6], P[BASE + 7]); \
    auto r0_ = __builtin_amdgcn_permlane32_swap(a0_, b0_, false, false); auto r1_ = __builtin_amdgcn_permlane32_swap(a1_, b1_, false, false); \
    u32x4 w_ = {r0_[0], r1_[0], r0_[1], r1_[1]}; OUT = __builtin_bit_cast(bf16x8, w_); } while (0)
__device__ __forceinline__ void pv_half0_sm1(f32x16* o, int vb, bf16x8 pa0, bf16x8 pa1, f32x16& p1, float& ps1, bf16x8& pa2, bf16x8& pa3) {
  TrFrag2 fa, fb; float s1 = 0.f;
  tr_frag2<0, 0>(fa, vb);
#define H0_STEP(G, CUR, NXT, FILL) do { tr_frag2<(G) + 1, 0>(NXT, vb); asm volatile("s_waitcnt lgkmcnt(4)" ::: "memory"); SBAR(); pv_mma2(o[G], CUR, pa0, pa1); FILL; SBAR(); } while (0)
  H0_STEP(0, fa, fb, { p1[0] = __builtin_amdgcn_exp2f(p1[0]); p1[1] = __builtin_amdgcn_exp2f(p1[1]); p1[2] = __builtin_amdgcn_exp2f(p1[2]); p1[3] = __builtin_amdgcn_exp2f(p1[3]); });
  H0_STEP(1, fb, fa, { p1[4] = __builtin_amdgcn_exp2f(p1[4]); p1[5] = __builtin_amdgcn_exp2f(p1[5]); p1[6] = __builtin_amdgcn_exp2f(p1[6]); p1[7] = __builtin_amdgcn_exp2f(p1[7]); });
  H0_STEP(2, fa, fb, { p1[8] = __builtin_amdgcn_exp2f(p1[8]); p1[9] = __builtin_amdgcn_exp2f(p1[9]); p1[10] = __builtin_amdgcn_exp2f(p1[10]); p1[11] = __builtin_amdgcn_exp2f(p1[11]); });
  H0_STEP(3, fb, fa, { p1[12] = __builtin_amdgcn_exp2f(p1[12]); p1[13] = __builtin_amdgcn_exp2f(p1[13]); p1[14] = __builtin_amdgcn_exp2f(p1[14]); p1[15] = __builtin_amdgcn_exp2f(p1[15]); });
  H0_STEP(4, fa, fb, { s1 = ((p1[0] + p1[1]) + (p1[2] + p1[3])) + ((p1[4] + p1[5]) + (p1[6] + p1[7])); });
  H0_STEP(5, fb, fa, { s1 += ((p1[8] + p1[9]) + (p1[10] + p1[11])) + ((p1[12] + p1[13]) + (p1[14] + p1[15])); });
  H0_STEP(6, fa, fb, { PKH(p1, 0, pa2); });
  asm volatile("s_waitcnt lgkmcnt(0)" ::: "memory"); SBAR(); pv_mma2(o[7], fb, pa0, pa1); PKH(p1, 8, pa3); SBAR();
  ps1 = s1;
#undef H0_STEP
}
__device__ __forceinline__ void pv_half1(f32x16* o, int vb, bf16x8 pa2, bf16x8 pa3) {
  TrFrag2 fa, fb;
  tr_frag2<0, 1>(fa, vb);
#define H1_STEP(G, CUR, NXT) do { tr_frag2<(G) + 1, 1>(NXT, vb); asm volatile("s_waitcnt lgkmcnt(4)" ::: "memory"); SBAR(); pv_mma2(o[G], CUR, pa2, pa3); SBAR(); } while (0)
  H1_STEP(0, fa, fb); H1_STEP(1, fb, fa); H1_STEP(2, fa, fb); H1_STEP(3, fb, fa); H1_STEP(4, fa, fb); H1_STEP(5, fb, fa); H1_STEP(6, fa, fb);
  asm volatile("s_waitcnt lgkmcnt(0)" ::: "memory"); SBAR(); pv_mma2(o[7], fb, pa2, pa3);
#undef H1_STEP
}

#define SM_PIN(v) asm volatile("" : "+v"(v))
#define SM_FE(P, r) P[r] = __builtin_amdgcn_exp2f(fmaf(P[r], SCALE * 1.4426950408889634f, mnC))
__device__ __forceinline__ void pv_half0_sm1b(f32x16* o, int vb, bf16x8 pa0, bf16x8 pa1, const f32x16& p0, f32x16& p1, float mnC, float& ps, bf16x8& pa2, bf16x8& pa3) {
  TrFrag2 fa, fb; float s0 = 0.f;
  tr_frag2<0, 0>(fa, vb);
#define H0_STEP(G, CUR, NXT, FILL) do { tr_frag2<(G) + 1, 0>(NXT, vb); asm volatile("s_waitcnt lgkmcnt(4)" ::: "memory"); SBAR(); pv_mma2(o[G], CUR, pa0, pa1); FILL; SBAR(); } while (0)
  H0_STEP(0, fa, fb, { s0 = (((p0[0] + p0[1]) + (p0[2] + p0[3])) + ((p0[4] + p0[5]) + (p0[6] + p0[7]))) + (((p0[8] + p0[9]) + (p0[10] + p0[11])) + ((p0[12] + p0[13]) + (p0[14] + p0[15]))); SM_PIN(s0); });
  H0_STEP(1, fb, fa, { SM_FE(p1, 0); SM_FE(p1, 1); SM_FE(p1, 2); SM_FE(p1, 3); });
  H0_STEP(2, fa, fb, { SM_FE(p1, 4); SM_FE(p1, 5); SM_FE(p1, 6); SM_FE(p1, 7); });
  H0_STEP(3, fb, fa, { SM_FE(p1, 8); SM_FE(p1, 9); SM_FE(p1, 10); SM_FE(p1, 11); });
  H0_STEP(4, fa, fb, { SM_FE(p1, 12); SM_FE(p1, 13); SM_FE(p1, 14); SM_FE(p1, 15); });
  H0_STEP(5, fb, fa, { PKH(p1, 0, pa2); s0 += ((p1[0] + p1[1]) + (p1[2] + p1[3])) + ((p1[4] + p1[5]) + (p1[6] + p1[7])); SM_PIN(s0); });
  H0_STEP(6, fa, fb, { PKH(p1, 8, pa3); });
  asm volatile("s_waitcnt lgkmcnt(0)" ::: "memory"); SBAR(); pv_mma2(o[7], fb, pa0, pa1); s0 += ((p1[8] + p1[9]) + (p1[10] + p1[11])) + ((p1[12] + p1[13]) + (p1[14] + p1[15])); SM_PIN(s0); SBAR();
  ps = s0;
#undef H0_STEP
}
__device__ __forceinline__ void pv_half1_sum(f32x16* o, int vb, bf16x8 pa2, bf16x8 pa3, float ps, float alpha, float& l_reg) {
  TrFrag2 fa, fb;
  tr_frag2<0, 1>(fa, vb);
#define H1_STEP(G, CUR, NXT, FILL) do { tr_frag2<(G) + 1, 1>(NXT, vb); asm volatile("s_waitcnt lgkmcnt(4)" ::: "memory"); SBAR(); pv_mma2(o[G], CUR, pa2, pa3); FILL; SBAR(); } while (0)
  H1_STEP(0, fa, fb, { auto rr = __builtin_amdgcn_permlane32_swap(__float_as_uint(ps), __float_as_uint(ps), false, false); ps = __uint_as_float(rr[0]) + __uint_as_float(rr[1]); l_reg = l_reg * alpha + ps; SM_PIN(l_reg); });
  H1_STEP(1, fb, fa, {});
  H1_STEP(2, fa, fb, {}); H1_STEP(3, fb, fa, {}); H1_STEP(4, fa, fb, {}); H1_STEP(5, fb, fa, {}); H1_STEP(6, fa, fb, {});
  asm volatile("s_waitcnt lgkmcnt(0)" ::: "memory"); SBAR(); pv_mma2(o[7], fb, pa2, pa3);
#undef H1_STEP
}

constexpr int F2_K = 0, F2_V = 32768, F2_WS = 98304;
__device__ __forceinline__ void flash_pass2(const bf16* __restrict__ Qb, const bf16* __restrict__ Kh, const bf16* __restrict__ Vh, int seq, char* lds, LAS unsigned char* ldsl, f32x16 (&o)[8], float& l_out, const int tid) {
  const int wid = __builtin_amdgcn_readfirstlane(tid >> 6), lane = tid & 63, r32 = lane & 31, hi = lane >> 5;
  float* ws = (float*)(lds + F2_WS) + wid * 64; float* al_l = ws + 32;
  float m_reg = -1e30f, l_reg = 0; bf16x8 qr[8];
#pragma unroll
  for (int d = 0; d < 8; ++d) o[d] = f32x16{};
  const bf16* Qw = Qb + (long)(wid * QBLK + r32) * LDX + hi * 8;
#pragma unroll
  for (int d0 = 0; d0 < 8; ++d0) qr[d0] = ld8(Qw + d0 * 16);
  unsigned ko[2], va[2], vb_[2];
#pragma unroll
  for (int i = 0; i < 2; ++i) { const int j = 2 * wid + i;
    { const int row = 4 * j + (lane >> 4), pc = lane & 15, lc = pc ^ (row & 7); ko[i] = (unsigned)(row * LDX + lc * 8) * 2u; }
    { const int S = 64 * j + lane, sub = S >> 5, kk = (sub >> 2) * 8 + ((S & 31) >> 2), c = (sub & 3) * 32 + (S & 3) * 8;
      const int k = (kk & ~0xC) | ((kk & 4) << 1) | ((kk & 8) >> 1);
      va[i] = (unsigned)(k * LDX + c) * 2u; vb_[i] = va[i] + 256u; } }
#define F2_DMA(t, b) do { const char* kb_ = (const char*)Kh + (size_t)(t) * (64 * LDX * 2); const char* vb2_ = (const char*)Vh + (size_t)(t) * (64 * LDX * 2); \
    _Pragma("unroll") for (int i_ = 0; i_ < 2; ++i_) { \
      __builtin_amdgcn_global_load_lds((const unsigned*)(kb_ + ko[i_]), (LAS unsigned*)(ldsl + F2_K + (b) * 16384 + (2 * wid + i_) * 1024), 16, 0, 0); \
      __builtin_amdgcn_global_load_lds((const unsigned*)(vb2_ + va[i_]), (LAS unsigned*)(ldsl + F2_V + (b) * 32768 + (2 * wid + i_) * 1024), 16, 0, 0); \
      __builtin_amdgcn_global_load_lds((const unsigned*)(vb2_ + vb_[i_]), (LAS unsigned*)(ldsl + F2_V + (b) * 32768 + 16384 + (2 * wid + i_) * 1024), 16, 0, 0); } } while (0)
  const int vbase = (int)(uintptr_t)lds + F2_V + v_rd_base(lane), kbase = (int)(uintptr_t)lds + F2_K + r32 * 256;
  const int NT = seq / KVBLK;
  __syncthreads();
  F2_DMA(0, 0);
#pragma unroll 1
  for (int j = 0; j < NT; ++j) {
    const int b = j & 1;
    asm volatile("s_waitcnt vmcnt(0)" ::: "memory");
    __syncthreads();
    if (j + 1 < NT) F2_DMA(j + 1, b ^ 1);
    f32x16 p0, p1; float mn, alpha; bf16x8 pa0, pa1, pa2, pa3;
    qkt_pipe(p0, p1, kbase + b * 16384, (r32 & 7) << 4, hi * 16, qr);
    float mnC; partialSM2(p0, p1, m_reg, alpha, mnC);
    if (__any(alpha < 1.f)) { if (hi == 0) al_l[r32] = alpha; asm volatile("s_waitcnt lgkmcnt(0)" ::: "memory");
#pragma unroll
      for (int d = 0; d < 8; ++d)
#pragma unroll
        for (int r = 0; r < 16; ++r) o[d][r] *= al_l[crow(r, hi)]; }
#ifndef ATT_HALFSM
#define ATT_HALFSM 1
#endif
#if ATT_HALFSM
    {
      PKH(p0, 0, pa0); PKH(p0, 8, pa1); SBAR();
      float ps;
      pv_half0_sm1b(o, vbase + b * 32768, pa0, pa1, p0, p1, mnC, ps, pa2, pa3);
      pv_half1_sum(o, vbase + b * 32768, pa2, pa3, ps, alpha, l_reg);
    }
#else
    finishSM(p0, p1, alpha, l_reg, pa0, pa1, pa2, pa3); SBAR();
#ifndef ATT_PVPIPE
#define ATT_PVPIPE 1
#endif
#if ATT_PVPIPE
    pv_pipe(o, vbase + b * 32768, pa0, pa1, pa2, pa3);
#else
    pv_d0(o, vbase + b * 32768, pa0, pa1, pa2, pa3);
    pv_d0(o + 4, vbase + b * 32768 + 16384, pa0, pa1, pa2, pa3);
#endif
#endif
  }
  l_out = l_reg;
#undef F2_DMA
}
__device__ __forceinline__ void diff_unit2(const bf16* __restrict__ QKV, float* __restrict__ DIFFO, int rb, int T, int h, int qb, float lam, char* lds, LAS unsigned char* ldsl, const int tid0) {
#pragma unroll 1
  for (int n = 0; n < 2; ++n) {
    { unsigned z = 0; asm volatile("" : "+s"(z)); QKV += z; }
    const bf16* Qb = QKV + (size_t)(rb + qb * 256) * LDX + 3072 + (h * 2 + n) * 128;
    const bf16* Kh = QKV + (size_t)rb * LDX + 4096 + (h * 2 + n) * 128;
    const bf16* Vh = QKV + (size_t)rb * LDX + 5120 + h * 256;
    f32x16 o[8]; float l_reg;
    flash_pass2(Qb, Kh, Vh, T, lds, ldsl, o, l_reg, tid0);
    int tid = tid0; asm volatile("" : "+v"(tid));
    const int wid = __builtin_amdgcn_readfirstlane(tid >> 6), lane = tid & 63, r32 = lane & 31, hi = lane >> 5;
    float* li_l = (float*)(lds + F2_WS) + wid * 64;
    float* Ow = DIFFO + (size_t)(rb + qb * 256 + wid * QBLK) * 1024 + h * 256 + r32;
    if (hi == 0) li_l[r32] = l_reg; asm volatile("s_waitcnt lgkmcnt(0)" ::: "memory");
    const float sgn = n ? -lam : 1.0f;
#pragma unroll
    for (int r = 0; r < 16; ++r) { const int orow = crow(r, hi); const float rl = __builtin_amdgcn_rcpf(li_l[orow]) * sgn;
#pragma unroll
      for (int d0 = 0; d0 < 8; ++d0) { float* p = Ow + (size_t)orow * 1024 + d0 * 32; float v = o[d0][r] * rl; if (n) v += *p; *p = v; } }
  }
}

using f32x4 = __attribute__((ext_vector_type(4))) float;
__device__ __forceinline__ unsigned a16_off_a(unsigned row, unsigned ch) { return 2048u * (row >> 3) + 512u * (ch >> 2) + 64u * (row & 7) + 16u * ((ch & 3) ^ ((row >> 2) & 3)); }
__device__ __forceinline__ unsigned a16_xb(unsigned row) { return ((row & 3) << 2) | ((row >> 2) & 3); }
__device__ __forceinline__ unsigned a16_off_b(unsigned row, unsigned ch) { return 256u * row + 16u * (ch ^ a16_xb(row)); }
template <int OFF> __device__ __forceinline__ bf16x8 k16_read(int a) { bf16x8 r; asm volatile("ds_read_b128 %0, %1 offset:%2" : "=&v"(r) : "v"(a), "i"(OFF) : "memory"); return r; }
#define MF16(A, B, C) __builtin_amdgcn_mfma_f32_16x16x32_bf16(A, B, C, 0, 0, 0)
#define A16_XMAX(x) do { { auto r_ = __builtin_amdgcn_permlane16_swap(__float_as_uint(x), __float_as_uint(x), false, false); x = fmaxf(__uint_as_float(r_[0]), __uint_as_float(r_[1])); } \
                         { auto r_ = __builtin_amdgcn_permlane32_swap(__float_as_uint(x), __float_as_uint(x), false, false); x = fmaxf(__uint_as_float(r_[0]), __uint_as_float(r_[1])); } } while (0)
#define A16_XSUM(x) do { { auto r_ = __builtin_amdgcn_permlane16_swap(__float_as_uint(x), __float_as_uint(x), false, false); x = __uint_as_float(r_[0]) + __uint_as_float(r_[1]); } \
                         { auto r_ = __builtin_amdgcn_permlane32_swap(__float_as_uint(x), __float_as_uint(x), false, false); x = __uint_as_float(r_[0]) + __uint_as_float(r_[1]); } } while (0)
struct VF16 { s16x4 t0, t1; };
__device__ __forceinline__ void flash_pass16(const bf16* __restrict__ Qb, const bf16* __restrict__ Kh, const bf16* __restrict__ Vh, int seq, char* lds, LAS unsigned char* ldsl, f32x4 (&o)[2][16], float (&l_out)[2], const int tid) {
  constexpr float C = SCALE * 1.4426950408889634f;
  int tid_l = tid; asm volatile("" : "+v"(tid_l));
  const int wid = __builtin_amdgcn_readfirstlane(tid_l >> 6), lane = tid_l & 63, c16 = lane & 15, g = lane >> 4;
  float* ws = (float*)(lds + F2_WS) + wid * 64; float* al_l = ws + 32;
  float m_reg[2] = {-1e30f, -1e30f}, l_reg[2] = {0.f, 0.f}; bf16x8 qr[2][4];
#pragma unroll
  for (int qt = 0; qt < 2; ++qt)
#pragma unroll
    for (int dt = 0; dt < 16; ++dt) o[qt][dt] = f32x4{0.f, 0.f, 0.f, 0.f};
#pragma unroll
  for (int qt = 0; qt < 2; ++qt)
#pragma unroll
    for (int s4 = 0; s4 < 4; ++s4) qr[qt][s4] = ld8(Qb + (long)(wid * QBLK + 16 * qt + c16) * LDX + 32 * s4 + 8 * g);
  unsigned ko[2], va[2];
#pragma unroll
  for (int i = 0; i < 2; ++i) { const unsigned S = 64u * (2 * wid + i) + lane;
    { const unsigned row = S >> 4, ch = (S & 15) ^ a16_xb(row); ko[i] = (row * LDX + 8 * ch) * 2u; }
    { const unsigned row = 8 * (S >> 7) + ((S >> 2) & 7), ch = 4 * ((S >> 5) & 3) + ((S & 3) ^ ((row >> 2) & 3)); va[i] = (row * LDX + 8 * ch) * 2u; } }
#define F16_DMA(t, b) do { const char* kb_ = (const char*)Kh + (size_t)(t) * (64 * LDX * 2); const char* vb2_ = (const char*)Vh + (size_t)(t) * (64 * LDX * 2); \
    _Pragma("unroll") for (int i_ = 0; i_ < 2; ++i_) { \
      __builtin_amdgcn_global_load_lds((const unsigned*)(kb_ + ko[i_]), (LAS unsigned*)(ldsl + F2_K + (b) * 16384 + (2 * wid + i_) * 1024), 16, 0, 0); \
      __builtin_amdgcn_global_load_lds((const unsigned*)(vb2_ + va[i_]), (LAS unsigned*)(ldsl + F2_V + (b) * 32768 + (2 * wid + i_) * 1024), 16, 0, 0); \
      __builtin_amdgcn_global_load_lds((const unsigned*)(vb2_ + va[i_] + 256), (LAS unsigned*)(ldsl + F2_V + (b) * 32768 + 16384 + (2 * wid + i_) * 1024), 16, 0, 0); } } while (0)
  int kad[2][4], vad[2][2];
  { const unsigned krow0 = 8 * (c16 >> 2) + (c16 & 3);
#pragma unroll
    for (int t = 0; t < 2; ++t)
#pragma unroll
      for (int s4 = 0; s4 < 4; ++s4) kad[t][s4] = (int)(uintptr_t)lds + F2_K + (int)a16_off_b(krow0 + 4 * t, 4 * s4 + g);
    const unsigned qd = c16 >> 2, pp = c16 & 3;
#pragma unroll
    for (int c1 = 0; c1 < 2; ++c1)
#pragma unroll
      for (int t = 0; t < 2; ++t) vad[c1][t] = (int)(uintptr_t)lds + F2_V + (int)(a16_off_a(8 * g + 4 * t + qd, 2 * c1 + (pp >> 1)) + 8 * (pp & 1)); }
  const int NT = seq / KVBLK;
  __syncthreads();
  F16_DMA(0, 0);
#pragma unroll 1
  for (int j = 0; j < NT; ++j) {
    const int b = j & 1;
    asm volatile("s_waitcnt vmcnt(0)" ::: "memory");
    __syncthreads();
    if (j + 1 < NT) F16_DMA(j + 1, b ^ 1);
    f32x4 st[4][2];
#pragma unroll
    for (int kt = 0; kt < 4; ++kt) { st[kt][0] = f32x4{0.f, 0.f, 0.f, 0.f}; st[kt][1] = st[kt][0]; }
    { const int kb = b * 16384; bf16x8 kf[4];
#define K16_RD(n) ((((n) & 3) >> 1) ? k16_read<8192>(kad[(n) & 1][(n) >> 2] + kb) : k16_read<0>(kad[(n) & 1][(n) >> 2] + kb))
      kf[0] = K16_RD(0); kf[1] = K16_RD(1); kf[2] = K16_RD(2);
#pragma unroll
      for (int n = 0; n < 16; ++n) { const int kt = n & 3, s4 = n >> 2;
        if (n + 3 < 16) { kf[(n + 3) & 3] = K16_RD(n + 3); asm volatile("s_waitcnt lgkmcnt(3)" ::: "memory"); }
        else if (n + 2 < 16) asm volatile("s_waitcnt lgkmcnt(2)" ::: "memory");
        else if (n + 1 < 16) asm volatile("s_waitcnt lgkmcnt(1)" ::: "memory");
        else asm volatile("s_waitcnt lgkmcnt(0)" ::: "memory");
        SBAR();
        st[kt][0] = MF16(kf[n & 3], qr[0][s4], st[kt][0]); st[kt][1] = MF16(kf[n & 3], qr[1][s4], st[kt][1]);
        SBAR(); }
#undef K16_RD
    }
    float alpha[2], mnC[2]; bool ok = true;
#pragma unroll
    for (int qt = 0; qt < 2; ++qt) {
      float c0 = fmaxf(fmaxf(st[0][qt][0], st[0][qt][1]), fmaxf(st[0][qt][2], st[0][qt][3])), c1 = fmaxf(fmaxf(st[1][qt][0], st[1][qt][1]), fmaxf(st[1][qt][2], st[1][qt][3]));
      float c2 = fmaxf(fmaxf(st[2][qt][0], st[2][qt][1]), fmaxf(st[2][qt][2], st[2][qt][3])), c3 = fmaxf(fmaxf(st[3][qt][0], st[3][qt][1]), fmaxf(st[3][qt][2], st[3][qt][3]));
      float pm = fmaxf(fmaxf(c0, c1), fmaxf(c2, c3)); A16_XMAX(pm);
      mnC[qt] = pm;
      ok = ok && (pm - m_reg[qt] <= THR / SCALE); }
    if (__builtin_expect(__all(ok), 1)) { alpha[0] = 1.f; alpha[1] = 1.f; }
    else {
#pragma unroll
      for (int qt = 0; qt < 2; ++qt) { const float mn = fmaxf(m_reg[qt], mnC[qt]); alpha[qt] = __builtin_amdgcn_exp2f((m_reg[qt] - mn) * C); m_reg[qt] = mn; }
      if (g == 0) { al_l[c16] = alpha[0]; al_l[16 + c16] = alpha[1]; } asm volatile("s_waitcnt lgkmcnt(0)" ::: "memory");
#pragma unroll
      for (int qt = 0; qt < 2; ++qt) { const f32x4 a4 = *(const f32x4*)(al_l + 16 * qt + 4 * g);
#pragma unroll
        for (int dt = 0; dt < 16; ++dt) { o[qt][dt][0] *= a4[0]; o[qt][dt][1] *= a4[1]; o[qt][dt][2] *= a4[2]; o[qt][dt][3] *= a4[3]; } }
    }
    mnC[0] = -m_reg[0] * C; mnC[1] = -m_reg[1] * C;
    bf16x8 pa[2][2]; float ps0 = 0.f, ps1 = 0.f;
#define FE16(kt, qt, i) st[kt][qt][i] = __builtin_amdgcn_exp2f(fmaf(st[kt][qt][i], C, mnC[qt]))
#define PK16(qt, ks) do { u32x4 w_ = {cvtpk(st[2 * (ks)][qt][0], st[2 * (ks)][qt][1]), cvtpk(st[2 * (ks)][qt][2], st[2 * (ks)][qt][3]), cvtpk(st[2 * (ks) + 1][qt][0], st[2 * (ks) + 1][qt][1]), cvtpk(st[2 * (ks) + 1][qt][2], st[2 * (ks) + 1][qt][3])}; \
      pa[qt][ks] = __builtin_bit_cast(bf16x8, w_); } while (0)
#define SUM8(qt, ka, kb2) (((st[ka][qt][0] + st[ka][qt][1]) + (st[ka][qt][2] + st[ka][qt][3])) + ((st[kb2][qt][0] + st[kb2][qt][1]) + (st[kb2][qt][2] + st[kb2][qt][3])))
#pragma unroll
    for (int qt = 0; qt < 2; ++qt) {
#pragma unroll
      for (int kt = 0; kt < 2; ++kt)
#pragma unroll
        for (int i = 0; i < 4; ++i) FE16(kt, qt, i);
      PK16(qt, 0); }
    SBAR();
    { const int vbo = b * 32768; VF16 vf[3];
#define V16_RD(F, n) do { constexpr int c_ = (n) & 7, img_ = ((n) >> 3) & 1, ks_ = (n) >> 4, OFF_ = 8192 * ks_ + 512 * (c_ >> 1) + 16384 * img_; \
        F.t0 = tr_read<OFF_>(vad[c_ & 1][0] + vbo); F.t1 = tr_read<OFF_>(vad[c_ & 1][1] + vbo); } while (0)
#define V16_STEP(n, CI, W, PF, FILL) do { PF; asm volatile("s_waitcnt lgkmcnt(" #W ")" ::: "memory"); SBAR(); \
        { const VF16& cu_ = vf[CI]; const bf16x8 vb8_ = (bf16x8){cu_.t0[0], cu_.t0[1], cu_.t0[2], cu_.t0[3], cu_.t1[0], cu_.t1[1], cu_.t1[2], cu_.t1[3]}; \
          o[0][(n) & 15] = MF16(pa[0][(n) >> 4], vb8_, o[0][(n) & 15]); o[1][(n) & 15] = MF16(pa[1][(n) >> 4], vb8_, o[1][(n) & 15]); } FILL; SBAR(); } while (0)
      V16_RD(vf[0], 0); V16_RD(vf[1], 1);
      V16_STEP(0, 0, 4, V16_RD(vf[2], 2), { ps0 = SUM8(0, 0, 1); SM_PIN(ps0); });
      V16_STEP(1, 1, 4, V16_RD(vf[0], 3), { ps1 = SUM8(1, 0, 1); SM_PIN(ps1); });
      V16_STEP(2, 2, 4, V16_RD(vf[1], 4), { FE16(2, 0, 0); FE16(2, 0, 1); });
      V16_STEP(3, 0, 4, V16_RD(vf[2], 5), { FE16(2, 0, 2); FE16(2, 0, 3); });
      V16_STEP(4, 1, 4, V16_RD(vf[0], 6), { FE16(2, 1, 0); FE16(2, 1, 1); });
      V16_STEP(5, 2, 4, V16_RD(vf[1], 7), { FE16(2, 1, 2); FE16(2, 1, 3); });
      V16_STEP(6, 0, 4, V16_RD(vf[2], 8), { FE16(3, 0, 0); FE16(3, 0, 1); });
      V16_STEP(7, 1, 4, V16_RD(vf[0], 9), { FE16(3, 0, 2); FE16(3, 0, 3); });
      V16_STEP(8, 2, 4, V16_RD(vf[1], 10), { FE16(3, 1, 0); FE16(3, 1, 1); });
      V16_STEP(9, 0, 4, V16_RD(vf[2], 11), { FE16(3, 1, 2); FE16(3, 1, 3); });
      V16_STEP(10, 1, 4, V16_RD(vf[0], 12), { ps0 += SUM8(0, 2, 3); SM_PIN(ps0); });
      V16_STEP(11, 2, 4, V16_RD(vf[1], 13), { ps1 += SUM8(1, 2, 3); SM_PIN(ps1); });
      V16_STEP(12, 0, 4, V16_RD(vf[2], 14), { PK16(0, 1); });
      V16_STEP(13, 1, 4, V16_RD(vf[0], 15), { PK16(1, 1); });
      V16_STEP(14, 2, 4, V16_RD(vf[1], 16), { l_reg[0] = l_reg[0] * alpha[0] + ps0; l_reg[1] = l_reg[1] * alpha[1] + ps1; SM_PIN(l_reg[0]); SM_PIN(l_reg[1]); });
      V16_STEP(15, 0, 4, V16_RD(vf[2], 17), {});
      V16_STEP(16, 1, 4, V16_RD(vf[0], 18), {});
      V16_STEP(17, 2, 4, V16_RD(vf[1], 19), {});
      V16_STEP(18, 0, 4, V16_RD(vf[2], 20), {});
      V16_STEP(19, 1, 4, V16_RD(vf[0], 21), {});
      V16_STEP(20, 2, 4, V16_RD(vf[1], 22), {});
      V16_STEP(21, 0, 4, V16_RD(vf[2], 23), {});
      V16_STEP(22, 1, 4, V16_RD(vf[0], 24), {});
      V16_STEP(23, 2, 4, V16_RD(vf[1], 25), {});
      V16_STEP(24, 0, 4, V16_RD(vf[2], 26), {});
      V16_STEP(25, 1, 4, V16_RD(vf[0], 27), {});
      V16_STEP(26, 2, 4, V16_RD(vf[1], 28), {});
      V16_STEP(27, 0, 4, V16_RD(vf[2], 29), {});
      V16_STEP(28, 1, 4, V16_RD(vf[0], 30), {});
      V16_STEP(29, 2, 4, V16_RD(vf[1], 31), {});
      V16_STEP(30, 0, 2, (void)0, {});
      V16_STEP(31, 1, 0, (void)0, {});
#undef V16_STEP
#undef V16_RD
    }
#undef FE16
#undef PK16
#undef SUM8
  }
#pragma unroll
  for (int qt = 0; qt < 2; ++qt) { float l = l_reg[qt]; A16_XSUM(l); l_out[qt] = l; }
#undef F16_DMA
}
#ifndef ATT16_SUBLN
#define ATT16_SUBLN 1
#endif
#define A16_DPP(v, ctrl) __builtin_bit_cast(float, __builtin_amdgcn_update_dpp(0, __builtin_bit_cast(int, v), ctrl, 0xf, 0xf, true))
__device__ __forceinline__ const char* a16_kptr(int k) { const __attribute__((address_space(4))) char* ka = (const __attribute__((address_space(4))) char*)__builtin_amdgcn_kernarg_segment_ptr(); unsigned z = 0; asm volatile("" : "+s"(z));
  return (const char*)*(const __attribute__((address_space(1))) char* const __attribute__((address_space(4)))*)(ka + z + 8 * k); }
__device__ __forceinline__ void diff_unit16(const bf16* __restrict__ QKV, float* __restrict__ DIFFO, int jlayer, int rb, int T, int h, int qb, float lam, char* lds, LAS unsigned char* ldsl, const int tid0) {
#pragma unroll 1
  for (int n = 0; n < 2; ++n) {
    { unsigned z = 0; asm volatile("" : "+s"(z)); QKV += z; }
    const bf16* Qb = QKV + (size_t)(rb + qb * 256) * LDX + 3072 + (h * 2 + n) * 128;
    const bf16* Kh = QKV + (size_t)rb * LDX + 4096 + (h * 2 + n) * 128;
    const bf16* Vh = QKV + (size_t)rb * LDX + 5120 + h * 256;
    f32x4 o[2][16]; float l2[2];
    flash_pass16(Qb, Kh, Vh, T, lds, ldsl, o, l2, tid0);
    int tid = tid0; asm volatile("" : "+v"(tid));
    const int wid = __builtin_amdgcn_readfirstlane(tid >> 6), lane = tid & 63, c16 = lane & 15, g = lane >> 4;
    float* li_l = (float*)(lds + F2_WS) + wid * 64;
    if (g == 0) { li_l[c16] = l2[0]; li_l[16 + c16] = l2[1]; } asm volatile("s_waitcnt lgkmcnt(0)" ::: "memory");
    const float sgn = n ? -lam : 1.0f;
#if ATT16_SUBLN
    if (n == 0) {
#endif
#pragma unroll
    for (int qt = 0; qt < 2; ++qt) { const f32x4 l4 = *(const f32x4*)(li_l + 16 * qt + 4 * g);
#pragma unroll
      for (int i = 0; i < 4; ++i) { const float rl = __builtin_amdgcn_rcpf(l4[i]) * sgn;
        float* Ow = DIFFO + (size_t)(rb + qb * 256 + wid * QBLK + 16 * qt + 4 * g + i) * 1024 + h * 256 + c16;
#pragma unroll
        for (int dt = 0; dt < 16; ++dt) { float* p = Ow + 16 * dt; float v = o[qt][dt][i] * rl; if (n) v += *p; *p = v; } } }
#if ATT16_SUBLN
    } else {
      const float* subw = (const float*)a16_kptr(16) + jlayer * 256; bf16* ATTO = (bf16*)a16_kptr(26) + (size_t)49152 * 2048;
      const float one_minus_li = jlayer ? 0.5292869816564158f : 0.8f;
      float gw[16];
#pragma unroll
      for (int dt = 0; dt < 16; ++dt) gw[dt] = subw[16 * dt + c16] * one_minus_li;
      const bool odd = c16 & 1;
#pragma unroll
      for (int qt = 0; qt < 2; ++qt) { const f32x4 l4 = *(const f32x4*)(li_l + 16 * qt + 4 * g);
#pragma unroll
        for (int i = 0; i < 4; ++i) { const float rl = __builtin_amdgcn_rcpf(l4[i]) * sgn;
          const size_t row = (size_t)(rb + qb * 256 + wid * QBLK + 16 * qt + 4 * g + i);
          const float* Ow = DIFFO + row * 1024 + h * 256 + c16;
          float o1[16];
#pragma unroll
          for (int dt = 0; dt < 16; ++dt) o1[dt] = Ow[16 * dt];
          float ss = 0.f;
#pragma unroll
          for (int dt = 0; dt < 16; ++dt) { const float v = fmaf(o[qt][dt][i], rl, o1[dt]); o1[dt] = v; ss = fmaf(v, v, ss); }
          ss += A16_DPP(ss, 0xB1); ss += A16_DPP(ss, 0x4E); ss += A16_DPP(ss, 0x141); ss += A16_DPP(ss, 0x140);
          const float r = __builtin_amdgcn_rsqf(ss * (1.0f / 256.0f) + 1e-6f);
          bf16* Ar = ATTO + row * 2048 + 1024 + h * 256 + (odd ? 16 + c16 - 1 : c16);
#pragma unroll
          for (int k = 0; k < 8; ++k) { const float a = o1[2 * k] * r * gw[2 * k], b2 = o1[2 * k + 1] * r * gw[2 * k + 1];
            const float snd = odd ? a : b2, rcv = A16_DPP(snd, 0xB1);
            *(unsigned*)(Ar + 32 * k) = odd ? cvtpk(rcv, b2) : cvtpk(a, rcv); } } }
    }
#endif
  }
}
#undef MF16

#ifndef NA_DMA
#define NA_DMA 1
#endif
#if NA_DMA
__device__ __forceinline__ void na_unit(const bf16* __restrict__ QKV, bf16* __restrict__ ATT, const float* __restrict__ rpb_h, int rb, int rows, int h, int band, char* lds, const int tid) {
  const int wid = __builtin_amdgcn_readfirstlane(tid >> 6), lane = tid & 63, r32 = lane & 31, hi = lane >> 5;
  LAS unsigned char* ldsl = (LAS unsigned char*)(unsigned)(uintptr_t)lds;
  float* ws = (float*)(lds + F2_WS) + wid * 64; float* li_l = ws; float* al_l = ws + 32;
  float* rpb_l = (float*)(lds + F2_WS + 2048);
  const int r0 = band * 4, r = r0 + (wid >> 1), cb = (wid & 1) * 32, c = cb + r32;
  const int rs = min(max(r - 4, 0), rows - 8), cs = min(max(c - 8, 0), 48);
  const int kr_lo = min(max(r0 - 4, 0), rows - 8), kr_hi = min(max(r0 - 1, 0), rows - 8) + 7;
  __syncthreads();
  for (int i = tid; i < 15 * 31; i += 512) rpb_l[i] = rpb_h[i];
  float m_reg = -1e30f, l_reg = 0; f32x16 o[4]; bf16x8 qr[8];
#pragma unroll
  for (int d = 0; d < 4; ++d) o[d] = f32x16{};
  const bf16* Qw = QKV + (size_t)(rb + r * 64 + c) * LDX + h * 128 + hi * 8;
#pragma unroll
  for (int d0 = 0; d0 < 8; ++d0) qr[d0] = ld8(Qw + d0 * 16);
  const bf16* Kh = QKV + (size_t)rb * LDX + 1024 + h * 128;
  const bf16* Vh = QKV + (size_t)rb * LDX + 2048 + h * 128;
  unsigned ko[2], va[2];
#pragma unroll
  for (int i = 0; i < 2; ++i) { const int j = 2 * wid + i;
    { const int row = 4 * j + (lane >> 4), pc = lane & 15, lc = pc ^ (row & 7); ko[i] = (unsigned)(row * LDX + lc * 8) * 2u; }
    { const int S = 64 * j + lane, sub = S >> 5, kk = (sub >> 2) * 8 + ((S & 31) >> 2), cc = (sub & 3) * 32 + (S & 3) * 8;
      const int k = (kk & ~0xC) | ((kk & 4) << 1) | ((kk & 8) >> 1);
      va[i] = (unsigned)(k * LDX + cc) * 2u; } }
#define NA_DMA_TILE(t, b) do { const char* kb_ = (const char*)Kh + (size_t)(t) * (64 * LDX * 2); const char* vb2_ = (const char*)Vh + (size_t)(t) * (64 * LDX * 2); \
    _Pragma("unroll") for (int i_ = 0; i_ < 2; ++i_) { \
      __builtin_amdgcn_global_load_lds((const unsigned*)(kb_ + ko[i_]), (LAS unsigned*)(ldsl + F2_K + (b) * 16384 + (2 * wid + i_) * 1024), 16, 0, 0); \
      __builtin_amdgcn_global_load_lds((const unsigned*)(vb2_ + va[i_]), (LAS unsigned*)(ldsl + F2_V + (b) * 32768 + (2 * wid + i_) * 1024), 16, 0, 0); } } while (0)
  const int vbase = (int)(uintptr_t)lds + F2_V + v_rd_base(lane), kbase = (int)(uintptr_t)lds + F2_K + r32 * 256;
  NA_DMA_TILE(kr_lo, 0);
#pragma unroll 1
  for (int kr = kr_lo; kr <= kr_hi; ++kr) {
    const int b = (kr - kr_lo) & 1;
    asm volatile("s_waitcnt vmcnt(0)" ::: "memory");
    __syncthreads();
    if (kr < kr_hi) NA_DMA_TILE(kr + 1, b ^ 1);
    if (kr >= rs && kr <= rs + 7) {
      f32x16 p0, p1; float mn, alpha; bf16x8 pa0, pa1, pa2, pa3;
      qkt_pipe(p0, p1, kbase + b * 16384, (r32 & 7) << 4, hi * 16, qr);
      const float* brow = rpb_l + (kr - r + 7) * 31 + (15 - c);
      constexpr float ISC = 1.0f / SCALE;
#pragma unroll
      for (int q = 0; q < 16; ++q) { const int kc = crow(q, hi);
        { const bool ok = (kc >= cs) && (kc < cs + 16); const float bb = brow[ok ? kc : cs]; p0[q] = ok ? fmaf(bb, ISC, p0[q]) : -INFINITY; }
        { const int k2 = kc + 32; const bool ok = (k2 >= cs) && (k2 < cs + 16); const float bb = brow[ok ? k2 : cs]; p1[q] = ok ? fmaf(bb, ISC, p1[q]) : -INFINITY; } }
      partialSM(p0, p1, m_reg, mn, alpha);
      RESC(alpha);
      finishSM(p0, p1, alpha, l_reg, pa0, pa1, pa2, pa3); SBAR();
      pv_pipe4(o, vbase + b * 32768, pa0, pa1, pa2, pa3);
    }
  }
#undef NA_DMA_TILE
  if (hi == 0) li_l[r32] = l_reg; asm volatile("s_waitcnt lgkmcnt(0)" ::: "memory");
  bf16* Ow = ATT + (size_t)(rb + r * 64 + cb) * 2048 + h * 128;
#pragma unroll
  for (int q = 0; q < 16; ++q) { const int orow = crow(q, hi); const float rl = __builtin_amdgcn_rcpf(li_l[orow]);
#pragma unroll
    for (int d0 = 0; d0 < 4; ++d0) { const unsigned w = cvtpk(o[d0][q] * rl, 0.f); Ow[(size_t)orow * 2048 + d0 * 32 + r32] = (bf16)(w & 0xffffu); } }
}
#else
__device__ __forceinline__ void na_unit(const bf16* __restrict__ QKV, bf16* __restrict__ ATT, const float* __restrict__ rpb_h, int rb, int rows, int h, int band, char* lds, const int tid) {
  const int wid = tid >> 6, lane = tid & 63, r32 = lane & 31, hi = lane >> 5;
  bf16* V_lds = (bf16*)lds; bf16* K_lds = (bf16*)(lds + 2 * SHM_V);
  float* ws = (float*)(lds + 2 * SHM_V + 2 * SHM_K) + wid * 64; float* li_l = ws; float* al_l = ws + 32;
  float* rpb_l = (float*)(lds + SHM_RPB);
  const int r0 = band * 4, r = r0 + (wid >> 1), cb = (wid & 1) * 32, c = cb + r32;
  const int rs = min(max(r - 4, 0), rows - 8), cs = min(max(c - 8, 0), 48);
  const int kr_lo = min(max(r0 - 4, 0), rows - 8), kr_hi = min(max(r0 - 1, 0), rows - 8) + 7;
  __syncthreads();
  for (int i = tid; i < 15 * 31; i += 512) rpb_l[i] = rpb_h[i];
  float m_reg = -1e30f, l_reg = 0; f32x16 o[4]; bf16x8 qr[8];
#pragma unroll
  for (int d = 0; d < 4; ++d) o[d] = f32x16{};
  const bf16* Qw = QKV + (size_t)(rb + r * 64 + c) * LDX + h * 128 + hi * 8;
#pragma unroll
  for (int d0 = 0; d0 < 8; ++d0) qr[d0] = ld8(Qw + d0 * 16);
  const bf16* Kh = QKV + (size_t)rb * LDX + 1024 + h * 128;
  const bf16* Vh = QKV + (size_t)rb * LDX + 2048 + h * 128;
  const int sr = tid >> 4, sc = (tid & 15) * 8, vst0 = v_st(sr, sc), vst1 = v_st(32 + sr, sc);
  const int vb0 = (int)(uintptr_t)V_lds + v_rd_base(lane);
  const unsigned vo0 = (unsigned)(sr * LDX + sc) * 2u;
  const __amdgpu_buffer_rsrc_t rsK = __builtin_amdgcn_make_buffer_rsrc((void*)Kh, (short)0, rows * 64 * (LDX * 2), 0x00020000), rsV = __builtin_amdgcn_make_buffer_rsrc((void*)Vh, (short)0, rows * 64 * (LDX * 2), 0x00020000);
  bf16x8 vs0, vs1, ks0, ks1;
  { const unsigned so_ = (unsigned)(kr_lo * 64) * (unsigned)(LDX * 2);
    vs0 = BLD(rsV, vo0, so_); vs1 = BLD(rsV, vo0, so_ + 32u * LDX * 2u); ks0 = BLD(rsK, vo0, so_); ks1 = BLD(rsK, vo0, so_ + 32u * LDX * 2u); }
#pragma unroll 1
  for (int kr = kr_lo; kr <= kr_hi; ++kr) {
    __syncthreads();
    *(bf16x8*)((char*)V_lds + vst0) = vs0; *(bf16x8*)((char*)V_lds + vst1) = vs1;
    *(bf16x8*)((char*)K_lds + KSWZ(sr, sc * 2)) = ks0; *(bf16x8*)((char*)K_lds + KSWZ(32 + sr, sc * 2)) = ks1;
    __syncthreads();
    if (kr < kr_hi) { const unsigned so_ = (unsigned)((kr + 1) * 64) * (unsigned)(LDX * 2);
      vs0 = BLD(rsV, vo0, so_); vs1 = BLD(rsV, vo0, so_ + 32u * LDX * 2u); ks0 = BLD(rsK, vo0, so_); ks1 = BLD(rsK, vo0, so_ + 32u * LDX * 2u); }
    if (kr >= rs && kr <= rs + 7) {
      f32x16 p0, p1; float mn, alpha; bf16x8 pa0, pa1, pa2, pa3;
      qkt(p0, p1, K_lds, qr, r32, hi);
      const float* brow = rpb_l + (kr - r + 7) * 31 + (15 - c);
      constexpr float ISC = 1.0f / SCALE;
#pragma unroll
      for (int q = 0; q < 16; ++q) { const int kc = crow(q, hi);
        { const bool ok = (kc >= cs) && (kc < cs + 16); const float b = brow[ok ? kc : cs]; p0[q] = ok ? fmaf(b, ISC, p0[q]) : -INFINITY; }
        { const int k2 = kc + 32; const bool ok = (k2 >= cs) && (k2 < cs + 16); const float b = brow[ok ? k2 : cs]; p1[q] = ok ? fmaf(b, ISC, p1[q]) : -INFINITY; } }
      partialSM(p0, p1, m_reg, mn, alpha);
      RESC(alpha);
      finishSM(p0, p1, alpha, l_reg, pa0, pa1, pa2, pa3); SBAR();
      pv_d0(o, vb0, pa0, pa1, pa2, pa3);
    }
  }
  if (hi == 0) li_l[r32] = l_reg; asm volatile("s_waitcnt lgkmcnt(0)" ::: "memory");
  bf16* Ow = ATT + (size_t)(rb + r * 64 + cb) * 2048 + h * 128;
#pragma unroll
  for (int q = 0; q < 16; ++q) { const int orow = crow(q, hi); const float rl = __builtin_amdgcn_rcpf(li_l[orow]);
#pragma unroll
    for (int d0 = 0; d0 < 4; ++d0) { const unsigned w = cvtpk(o[d0][q] * rl, 0.f); Ow[(size_t)orow * 2048 + d0 * 32 + r32] = (bf16)(w & 0xffffu); } }
}
#endif
#undef SWRITE
#undef RESC
#undef BLD
#undef KSWZ
#undef SBAR
}

#define XB_TMO      128
#define XB_XCNT(j)  (256  + 64 * (j))
#define XB_XSUB(j)  (1280 + 64 * (j))
#define XB_XGEN(j)  (2304 + 64 * (j))
#define XB_TOP      3328
#define XB_TOPGEN   3392
#define XCD_BAR_WORDS 3456
#define XB_SPIN_CAP (1u << 18)

__device__ __forceinline__ unsigned xb_ld(unsigned* p)              { return __hip_atomic_load(p, __ATOMIC_RELAXED, __HIP_MEMORY_SCOPE_AGENT); }
__device__ __forceinline__ unsigned xb_add(unsigned* p, unsigned v) { return __hip_atomic_fetch_add(p, v, __ATOMIC_RELAXED, __HIP_MEMORY_SCOPE_AGENT); }
__device__ __forceinline__ unsigned xb_xcc_id() { return (unsigned)__builtin_amdgcn_s_getreg((3 << 11) | 20) & 0xFu; }
#define XB_SPIN(cond, bar) do { unsigned _sp = 0; while (cond) { __builtin_amdgcn_s_sleep(1); \
    if ((++_sp & 255u) == 0u) { if (xb_ld(&(bar)[XB_TMO])) break; if (_sp > XB_SPIN_CAP) { atomicAdd(&(bar)[XB_TMO], 1u); break; } } } } while (0)

__device__ __forceinline__ unsigned xb_lane() { unsigned l; asm volatile("v_mbcnt_lo_u32_b32 %0, -1, 0\n\tv_mbcnt_hi_u32_b32 %0, -1, %0" : "=v"(l)); return l; }
struct XcdBarrier {
    unsigned wave;
    unsigned* bar; unsigned x;
    volatile LAS unsigned* st;
};

__device__ __forceinline__ XcdBarrier xcd_barrier_post(unsigned* bar, volatile LAS unsigned* st, unsigned wave) {
    XcdBarrier b; b.wave = wave; b.bar = bar; b.x = xb_xcc_id(); b.st = st;
    if (wave == 0u && xb_lane() == 0u) (void)xb_add(&bar[XB_XCNT(b.x)], 1u);
    return b;
}
__device__ __forceinline__ void xcd_barrier_complete(unsigned* bar, unsigned x, unsigned& nloc, unsigned& nx) {
    const unsigned G = gridDim.x * gridDim.y * gridDim.z;
    unsigned sum, cnt, mine, sp = 0u;
    for (;;) {
        sum = 0u; cnt = 0u; mine = 0u;
#pragma unroll
        for (unsigned j = 0; j < 16; ++j) { const unsigned c = xb_ld(&bar[XB_XCNT(j)]); sum += c; cnt += (c > 0u) ? 1u : 0u; mine = (j == x) ? c : mine; }
        if (sum == G) break;
        __builtin_amdgcn_s_sleep(1);
        if ((++sp & 255u) == 0u) { if (xb_ld(&bar[XB_TMO])) break; if (sp > XB_SPIN_CAP) { atomicAdd(&bar[XB_TMO], 1u); break; } }
    }
    nloc = mine > 0u ? mine : 1u; nx = cnt > 0u ? cnt : 1u;
}

__device__ __forceinline__ void xcd_barrier(const XcdBarrier& b) {
    asm volatile("s_waitcnt vmcnt(0)" ::: "memory");
    __syncthreads();
    if (b.wave == 0u && xb_lane() == 0u) {
        unsigned* bar = b.bar; unsigned bx_ = b.x; { unsigned z_ = 0; asm volatile("" : "+s"(z_)); bar += z_; bx_ += z_; }
        __builtin_amdgcn_s_waitcnt(0);
        unsigned nloc = b.st[0], nx = b.st[1];
        if (nloc == 0u) { xcd_barrier_complete(bar, bx_, nloc, nx); b.st[0] = nloc; b.st[1] = nx; }
        const unsigned old = xb_add(&bar[XB_XSUB(bx_)], 1u);
        const unsigned gen = old / nloc;
        if (old + 1u == (gen + 1u) * nloc) {
            __builtin_amdgcn_fence(__ATOMIC_RELEASE, "agent");
            asm volatile("s_waitcnt vmcnt(0)" ::: "memory");
            const unsigned og = xb_add(&bar[XB_TOP], 1u);
            const unsigned tg = og / nx;
            if (og + 1u == (tg + 1u) * nx) xb_add(&bar[XB_TOPGEN], 1u);
            else XB_SPIN(xb_ld(&bar[XB_TOPGEN]) == tg, bar);
            __builtin_amdgcn_fence(__ATOMIC_ACQUIRE, "agent");
            xb_add(&bar[XB_XGEN(bx_)], 1u);
            asm volatile("s_waitcnt vmcnt(0)" ::: "memory");
        } else {
            XB_SPIN(xb_ld(&bar[XB_XGEN(bx_)]) == gen, bar);
            __builtin_amdgcn_fence(__ATOMIC_ACQUIRE, "agent");
            asm volatile("s_waitcnt vmcnt(0)" ::: "memory");
        }
    }
    __syncthreads();
}

constexpr int DM = 2048, FF = 5632, MROWS = 49152, NLAYER = 4;
constexpr int T_PROMPT = 16384, T_SAMPLE = 2048, ROWS_PROMPT = 32768;
constexpr int NSEQ = 10;
constexpr float NORM_EPS = 1e-6f;
constexpr int NWAVES = 8;
constexpr size_t MiB = 1u << 20;
constexpr size_t WS_CTL = 0, CTL_ZERO_BYTES = 1 * MiB;
constexpr size_t WS_ADA = 2 * MiB;
constexpr size_t WS_ROT = 4 * MiB;
constexpr size_t WS_W_AIN = 8 * MiB;
constexpr size_t WS_W_AOUT = WS_W_AIN + 48 * MiB;
constexpr size_t WS_W_GLU = WS_W_AOUT + 16 * MiB;
constexpr size_t WS_W_FIN = WS_W_GLU + 32 * MiB;
constexpr size_t WS_W_FOUT = WS_W_FIN + 176 * MiB;
constexpr size_t WS_H = WS_W_FOUT + 88 * MiB;
constexpr size_t WS_ATT = WS_H + 192 * MiB;
constexpr size_t WS_MIX = WS_ATT + 192 * MiB;
constexpr size_t WS_BIG = WS_MIX + 192 * MiB;
constexpr size_t WS_S5LAM = WS_BIG + 576 * MiB;
constexpr size_t WS_S5L64 = WS_S5LAM + 1 * MiB;
constexpr size_t WS_S5BOP = WS_S5LAM + 2 * MiB;
constexpr size_t WS_S5COP = WS_S5LAM + 4 * MiB;
constexpr size_t WS_END = WS_S5LAM + 6 * MiB;
static_assert(WS_H == 368 * MiB && WS_END == 1526 * MiB, "ws map");
constexpr int S5_L = 64, S5_NCH = MROWS / S5_L;
constexpr size_t S5_STATE_BYTES = (size_t)2 * 128 * S5_NCH * 64 * 8;
constexpr size_t WS_S5E = WS_BIG, WS_S5X = WS_BIG + 128 * MiB;
static_assert(S5_STATE_BYTES <= 128 * MiB, "s5 state");
constexpr int CW_BAR = 4096;
constexpr int CW_NORM = 65536, NORM_BANK = 24 * 64;
static_assert((CW_NORM + 8 * NORM_BANK) * 4 <= (int)CTL_ZERO_BYTES, "counters inside the per-call memset");
constexpr int RING_BYTES = 131072;
constexpr int LDSCTL_OFF = RING_BYTES, MISC_OFF = LDSCTL_OFF + 320;
constexpr int LDS_BYTES = 147456;

#ifndef MERGED_V
#define MERGED_V 1
#endif
#define GAS __attribute__((address_space(1)))
typedef unsigned short bf16;
typedef unsigned v4u __attribute__((ext_vector_type(4)));
typedef unsigned v2u __attribute__((ext_vector_type(2)));
typedef float f32x4 __attribute__((ext_vector_type(4)));
typedef float f32x16 __attribute__((ext_vector_type(16)));
typedef short bf16x8 __attribute__((ext_vector_type(8)));
#define LDS_WAIT() asm volatile("s_waitcnt lgkmcnt(0)" ::: "memory")
#define VM_WAIT() asm volatile("s_waitcnt vmcnt(0)" ::: "memory")
__device__ __forceinline__ unsigned pk2(float lo, float hi) { typedef __bf16 bfx2_ __attribute__((ext_vector_type(2))); typedef float flx2_ __attribute__((ext_vector_type(2))); const flx2_ v_ = {lo, hi}; return __builtin_bit_cast(unsigned, __builtin_convertvector(v_, bfx2_)); }
__device__ __forceinline__ float bf_lo(unsigned w) { return __uint_as_float(w << 16); }
__device__ __forceinline__ float bf_hi(unsigned w) { return __uint_as_float(w & 0xffff0000u); }
#define WS_DPP(v, ctrl) __builtin_bit_cast(float, __builtin_amdgcn_update_dpp(0, __builtin_bit_cast(int, v), ctrl, 0xf, 0xf, true))
__device__ __forceinline__ float wave_sum(float v) {
    v += WS_DPP(v, 0xB1); v += WS_DPP(v, 0x4E); v += WS_DPP(v, 0x141); v += WS_DPP(v, 0x140);
    v += __builtin_bit_cast(float, __builtin_amdgcn_ds_swizzle(__builtin_bit_cast(int, v), 0x401F));
    { auto rr = __builtin_amdgcn_permlane32_swap(__float_as_uint(v), __float_as_uint(v), false, false); v = __uint_as_float(rr[0]) + __uint_as_float(rr[1]); }
    return v;
}
__device__ __forceinline__ int seq_of_row(int m) { return m < ROWS_PROMPT ? (m >> 14) : 2 + ((m - ROWS_PROMPT) >> 11); }
__device__ __forceinline__ int pos_of_row(int m) { return m < ROWS_PROMPT ? (m & (T_PROMPT - 1)) : ((m - ROWS_PROMPT) & (T_SAMPLE - 1)); }

#define XBUF(F) ((bf16*)((F).ws + WS_H))
#define HBUF(F) ((bf16*)(F).out)
#define ATTBUF(F) ((bf16*)(F).out + (size_t)MROWS * DM)
struct Args { const float* in[26]; float* out; unsigned char* ws; int ph_lo, ph_hi; };
static_assert(sizeof(Args) == 28 * 8 + 8, "Args has no padding");
__device__ __forceinline__ const float* inptr(int k) { const __attribute__((address_space(4))) char* ka = (const __attribute__((address_space(4))) char*)__builtin_amdgcn_kernarg_segment_ptr(); unsigned z = 0; asm volatile("" : "+s"(z));
    return (const float*)*(const GAS float* const __attribute__((address_space(4)))*)(ka + z + 8 * k); }
struct Frame {
    LAS unsigned char* lds; char* ldsg;
    int tid, lane, wave, vcu, G, gw, NGW;
    float* out; unsigned char* ws;
};

__device__ __forceinline__ void transpose_item(const float* W, int K, int N, bf16* WT, int gate_half, LAS float* scr, int item, int lane) {
    const int nblk = N / 32, kb = item / nblk, nb = item % nblk, k0 = 64 * kb, n0 = 32 * nb;
#pragma unroll 8
    for (int i = 0; i < 32; ++i) { const int kk = 2 * i + (lane >> 5); scr[kk * 33 + (lane & 31)] = W[(size_t)(k0 + kk) * N + n0 + (lane & 31)]; }
    LDS_WAIT(); asm volatile("" ::: "memory");
    int d0 = n0;
    if (gate_half > 0) { d0 = (n0 < gate_half) ? ((n0 >> 7) * 256 + (n0 & 127)) : ((((n0 - gate_half) >> 7) * 256) + 128 + ((n0 - gate_half) & 127)); }
    const int c = lane & 7;
#pragma unroll
    for (int j = 0; j < 4; ++j) { const int n = (lane >> 3) + 8 * j; const LAS float* s = scr + (8 * c) * 33 + n;
        v4u o; o.x = pk2(s[0 * 33], s[1 * 33]); o.y = pk2(s[2 * 33], s[3 * 33]); o.z = pk2(s[4 * 33], s[5 * 33]); o.w = pk2(s[6 * 33], s[7 * 33]);
        *(GAS v4u*)(WT + (size_t)(d0 + n) * K + k0 + 8 * c) = o; }
    LDS_WAIT(); asm volatile("" ::: "memory");
}

__device__ __forceinline__ void p0_prologue(Frame& F, const Args& KA) {
    LAS float* scr = (LAS float*)(F.lds + F.wave * 16384);
    constexpr int I_AIN = (DM / 64) * (6144 / 32), I_AOUT = (DM / 64) * (DM / 32), I_GLU = (DM / 64) * (4096 / 32), I_FIN = (DM / 64) * (2 * FF / 32), I_FOUT = (FF / 64) * (DM / 32);
    constexpr int NITEMS = 2 * I_AIN + 2 * I_AOUT + 2 * I_GLU + 4 * I_FIN + 4 * I_FOUT;
    for (int it = F.gw; it < NITEMS; it += F.NGW) {
        int r = it;
        if (r < 2 * I_AIN) { const int j = r / I_AIN; transpose_item(inptr(12) + (size_t)j * DM * 6144, DM, 6144, (bf16*)(F.ws + WS_W_AIN) + (size_t)j * 6144 * DM, 0, scr, r % I_AIN, F.lane); continue; } r -= 2 * I_AIN;
        if (r < 2 * I_AOUT) { const int j = r / I_AOUT; transpose_item(inptr(13) + (size_t)j * DM * DM, DM, DM, (bf16*)(F.ws + WS_W_AOUT) + (size_t)j * DM * DM, 0, scr, r % I_AOUT, F.lane); continue; } r -= 2 * I_AOUT;
        if (r < 2 * I_GLU) { const int j = r / I_GLU; transpose_item(inptr(25) + (size_t)j * DM * 4096, DM, 4096, (bf16*)(F.ws + WS_W_GLU) + (size_t)j * 4096 * DM, 2048, scr, r % I_GLU, F.lane); continue; } r -= 2 * I_GLU;
        if (r < 4 * I_FIN) { const int j = r / I_FIN; transpose_item(inptr(10) + (size_t)j * DM * 2 * FF, DM, 2 * FF, (bf16*)(F.ws + WS_W_FIN) + (size_t)j * 2 * FF * DM, FF, scr, r % I_FIN, F.lane); continue; } r -= 4 * I_FIN;
        { const int j = r / I_FOUT; transpose_item(inptr(11) + (size_t)j * FF * DM, FF, DM, (bf16*)(F.ws + WS_W_FOUT) + (size_t)j * DM * FF, 0, scr, r % I_FOUT, F.lane); }
    }
    {
        float* rot = (float*)(F.ws + WS_ROT);
        for (int e = F.gw * 64 + F.lane; e < T_PROMPT * 16; e += F.NGW * 64) {
            const int t = e >> 4, i = e & 15;
            double fr = 1.0;
            switch (i) { case 1: fr = 0.44036660267178046; break; case 2: fr = 0.19392274474868576; break; case 3: fr = 0.08539710028576561; break; case 4: fr = 0.03760603093086393; break;
                case 5: fr = 0.016560440080994446; break; case 6: fr = 0.007292664737217109; break; case 7: fr = 0.003211445994752591; break; case 8: fr = 0.001414213562373095; break;
                case 9: fr = 0.000622772421914596; break; case 10: fr = 0.0002742481756762073; break; case 11: fr = 0.00012076973741146504; break; case 12: fr = 5.318295896944988e-05; break;
                case 13: fr = 2.341999896140934e-05; break; case 14: fr = 1.031338537721246e-05; break; case 15: fr = 4.5416704806078695e-06; break; default: break; }
            const double ang = (double)t * fr;
            const double n = __builtin_rint(ang * 0.15915494309189535);
            double x = __builtin_fma(-n, 6.283185307179586, ang); x = __builtin_fma(-n, 2.4492935982947064e-16, x);
            const double x2 = x * x;
            double cs = 2.4795962632247972e-27, sn = 9.183689863795546e-29;
            cs = __builtin_fma(cs, -x2, 1.6117375710961184e-24); sn = __builtin_fma(sn, -x2, 6.446950284384474e-26);
            cs = __builtin_fma(cs, -x2, 8.896791392450574e-22);  sn = __builtin_fma(sn, -x2, 3.8681701706306835e-23);
            cs = __builtin_fma(cs, -x2, 4.110317623312165e-19);  sn = __builtin_fma(sn, -x2, 1.9572941063391263e-20);
            cs = __builtin_fma(cs, -x2, 1.5619206968586225e-16); sn = __builtin_fma(sn, -x2, 8.22063524662433e-18);
            cs = __builtin_fma(cs, -x2, 4.779477332387385e-14);  sn = __builtin_fma(sn, -x2, 2.8114572543455206e-15);
            cs = __builtin_fma(cs, -x2, 1.1470745597729725e-11); sn = __builtin_fma(sn, -x2, 7.647163731819816e-13);
            cs = __builtin_fma(cs, -x2, 2.08767569878681e-09);   sn = __builtin_fma(sn, -x2, 1.6059043836821613e-10);
            cs = __builtin_fma(cs, -x2, 2.755731922398589e-07);  sn = __builtin_fma(sn, -x2, 2.505210838544172e-08);
            cs = __builtin_fma(cs, -x2, 2.48015873015873e-05);   sn = __builtin_fma(sn, -x2, 2.7557319223985893e-06);
            cs = __builtin_fma(cs, -x2, 0.001388888888888889);   sn = __builtin_fma(sn, -x2, 0.0001984126984126984);
            cs = __builtin_fma(cs, -x2, 0.041666666666666664);   sn = __builtin_fma(sn, -x2, 0.008333333333333333);
            cs = __builtin_fma(cs, -x2, 0.5);                    sn = __builtin_fma(sn, -x2, 0.16666666666666666);
            cs = __builtin_fma(cs, -x2, 1.0);                    sn = __builtin_fma(sn, -x2, 1.0);
            sn = sn * x;
            rot[2 * e] = (float)cs; rot[2 * e + 1] = (float)sn;
        }
    }
    __syncthreads();
    {
        LAS float* sil = (LAS float*)F.lds;
        LAS float* red = (LAS float*)(F.lds + 81920);
        const int nunits = NLAYER * 48;
        if (F.vcu < nunits) {
            for (int i = F.tid; i < NSEQ * DM; i += NWAVES * 64) { const int s = i >> 11, k = i & (DM - 1); const float c = (s < 2) ? inptr(2)[s * DM + k] : inptr(3)[(s - 2) * DM + k]; sil[i] = c * __builtin_amdgcn_rcpf(1.0f + __expf(-c)); }
        }
        __syncthreads();
        for (int unit = F.vcu; unit < nunits; unit += F.G) {
            const int li = unit / 48, cbk = unit % 48, col = cbk * 256 + F.lane * 4;
            f32x4 acc[NSEQ];
#pragma unroll
            for (int s = 0; s < NSEQ; ++s) acc[s] = (f32x4){0.f, 0.f, 0.f, 0.f};
            const float* W = inptr(4) + ((size_t)li * DM + F.wave * 256) * 12288 + col;
#pragma unroll 4
            for (int kk = 0; kk < 256; ++kk) { const f32x4 w4 = *(const f32x4*)(W + (size_t)kk * 12288); const int k = F.wave * 256 + kk;
#pragma unroll
                for (int s = 0; s < NSEQ; ++s) acc[s] += sil[s * DM + k] * w4; }
#pragma unroll 1
            for (int rr = 0; rr < 2; ++rr) {
                __syncthreads();
#pragma unroll
                for (int s5 = 0; s5 < 5; ++s5)
#pragma unroll
                    for (int j = 0; j < 4; ++j) red[(F.wave * 20 + s5 * 4 + j) * 64 + F.lane] = rr ? acc[5 + s5][j] : acc[s5][j];
                __syncthreads();
                for (int i = F.tid; i < 20 * 64; i += NWAVES * 64) { float v = 0.f;
#pragma unroll
                    for (int w = 0; w < 8; ++w) v += red[w * 1280 + i];
                    const int sj = i >> 6, ln = i & 63, s = rr * 5 + (sj >> 2), j = sj & 3, cc = cbk * 256 + ln * 4 + j;
                    ((float*)(F.ws + WS_ADA))[((size_t)li * NSEQ + s) * 12288 + cc] = v + inptr(5)[li * 12288 + cc]; }
            }
        }
    }
}

template <int MODE> __device__ __forceinline__ void norm_block(const float* ADA, const bf16* MIX, bf16* H, bf16* XB, float* OUT, int lane, int m0, int nrows, int lpost, int spost, int lpre, int spre) {
    int cur_s = -1; float A[32], Bm[32], Cs[32];
#pragma unroll
    for (int i = 0; i < 32; ++i) { A[i] = 0.f; Bm[i] = 0.f; Cs[i] = 0.f; }
#pragma unroll 1
    for (int rr = 0; rr < nrows; ++rr) {
        const int m = m0 + rr; const int s = seq_of_row(m);
        if (s != cur_s) {
            cur_s = s;
#pragma unroll
            for (int j = 0; j < 8; ++j) { const int c = 256 * j + 4 * lane;
                if (MODE != 0) { const f32x4 gt = *(const f32x4*)(ADA + ((size_t)lpost * NSEQ + s) * 12288 + (spost ? 5 : 2) * DM + c); const f32x4 gp = *(const f32x4*)(inptr(spost ? 9 : 7) + lpost * DM + c);
#pragma unroll
                    for (int e = 0; e < 4; ++e) A[4 * j + e] = gt[e] * gp[e]; }
                if (MODE != 2) { const f32x4 sh = *(const f32x4*)(ADA + ((size_t)lpre * NSEQ + s) * 12288 + (spre ? 3 : 0) * DM + c); const f32x4 sc = *(const f32x4*)(ADA + ((size_t)lpre * NSEQ + s) * 12288 + (spre ? 4 : 1) * DM + c);
                    const f32x4 gq = *(const f32x4*)(inptr(spre ? 8 : 6) + lpre * DM + c);
#pragma unroll
                    for (int e = 0; e < 4; ++e) { Bm[4 * j + e] = gq[e] * (1.0f + sc[e]); Cs[4 * j + e] = sh[e]; } }
                asm volatile("" ::: "memory");
            }
        }
        f32x4 xv[8];
        if (MODE == 0) { const float* xin = (m < ROWS_PROMPT ? inptr(0) + (size_t)m * DM : inptr(1) + (size_t)(m - ROWS_PROMPT) * DM);
#pragma unroll
            for (int j = 0; j < 8; ++j) xv[j] = *(const f32x4*)(xin + 256 * j + 4 * lane); }
        else {
#pragma unroll
            for (int j = 0; j < 8; ++j) { const v2u xw = __builtin_nontemporal_load((const v2u*)(XB + (size_t)m * DM + 256 * j + 4 * lane)); xv[j] = (f32x4){bf_lo(xw.x), bf_hi(xw.x), bf_lo(xw.y), bf_hi(xw.y)}; } }
        if (MODE != 0) {
            v2u mv[8]; float ss = 0.f;
#pragma unroll
            for (int j = 0; j < 8; ++j) mv[j] = __builtin_nontemporal_load((const v2u*)(MIX + (size_t)m * DM + 256 * j + 4 * lane));
            float mf[32];
#pragma unroll
            for (int j = 0; j < 8; ++j) { mf[4 * j] = bf_lo(mv[j].x); mf[4 * j + 1] = bf_hi(mv[j].x); mf[4 * j + 2] = bf_lo(mv[j].y); mf[4 * j + 3] = bf_hi(mv[j].y); }
#pragma unroll
            for (int i = 0; i < 32; ++i) ss += mf[i] * mf[i];
            ss = wave_sum(ss); const float rstd = __builtin_amdgcn_rsqf(ss * (1.0f / DM) + NORM_EPS);
#pragma unroll
            for (int j = 0; j < 8; ++j)
#pragma unroll
                for (int e = 0; e < 4; ++e) xv[j][e] += A[4 * j + e] * (mf[4 * j + e] * rstd);
        }
        if (MODE == 2) { float* xo = OUT + (size_t)m * DM;
#pragma unroll
            for (int j = 0; j < 8; ++j) *(f32x4*)(xo + 256 * j + 4 * lane) = xv[j]; }
        else {
#pragma unroll
            for (int j = 0; j < 8; ++j) { v2u w; w.x = pk2(xv[j][0], xv[j][1]); w.y = pk2(xv[j][2], xv[j][3]); __builtin_nontemporal_store(w, (v2u*)(XB + (size_t)m * DM + 256 * j + 4 * lane)); } }
        if (MODE != 2) {
            float s2 = 0.f;
#pragma unroll
            for (int j = 0; j < 8; ++j) s2 += (xv[j][0] * xv[j][0] + xv[j][1] * xv[j][1]) + (xv[j][2] * xv[j][2] + xv[j][3] * xv[j][3]);
            s2 = wave_sum(s2); const float r2 = __builtin_amdgcn_rsqf(s2 * (1.0f / DM) + NORM_EPS);
#pragma unroll
            for (int j = 0; j < 8; ++j) { v2u w;
                w.x = pk2(xv[j][0] * r2 * Bm[4 * j] + Cs[4 * j], xv[j][1] * r2 * Bm[4 * j + 1] + Cs[4 * j + 1]);
                w.y = pk2(xv[j][2] * r2 * Bm[4 * j + 2] + Cs[4 * j + 2], xv[j][3] * r2 * Bm[4 * j + 3] + Cs[4 * j + 3]);
                *(v2u*)(H + (size_t)m * DM + 256 * j + 4 * lane) = w; }
        }
    }
}
template <int MODE> __device__ __forceinline__ void norm_phase(Frame& F, const Args& KA, int lpost, int spost, int lpre, int spre) {
    for (int blk = F.gw; blk < MROWS / 24; blk += F.NGW)
        norm_block<MODE>((const float*)(F.ws + WS_ADA), (const bf16*)(F.ws + WS_MIX), HBUF(F), XBUF(F), F.out, F.lane, blk * 24, 24, lpost, spost, lpre, spre);
}
template <int MODE> struct NormOrder : pg8::StaticOrder {
    unsigned* cnt; volatile LAS unsigned* flag; const float* ADA; const bf16* MIX; bf16* H; bf16* XB; float* OUT; int lpost, spost, lpre, spre, wave, lane;
    __device__ __forceinline__ void done(const pg8::Unit& u) const {
        asm volatile("s_waitcnt vmcnt(0)" ::: "memory");
        asm volatile("" ::: "memory"); __builtin_amdgcn_s_barrier(); asm volatile("" ::: "memory");
        const int gidx = u.pm >> 3; const bool last_of_group = u.pn >= nN - 4;
        if (wave == 0) {
            if (lane == 0) (void)__hip_atomic_fetch_add(cnt + 64 * gidx, 1u, __ATOMIC_RELAXED, __HIP_MEMORY_SCOPE_AGENT);
            if (last_of_group) {
                const unsigned want = 8u * (unsigned)nN; unsigned spins = 0u;
                while ((unsigned)__builtin_amdgcn_readfirstlane(__hip_atomic_load(cnt + 64 * gidx, __ATOMIC_RELAXED, __HIP_MEMORY_SCOPE_AGENT)) < want) { __builtin_amdgcn_s_sleep(2); if (++spins > (1u << 22)) break; }
                __builtin_amdgcn_fence(__ATOMIC_ACQUIRE, "agent"); asm volatile("s_waitcnt vmcnt(0)" ::: "memory");
            }
        }
        if (last_of_group) {
            asm volatile("" ::: "memory"); __builtin_amdgcn_s_barrier(); asm volatile("" ::: "memory");
            norm_block<MODE>(ADA, MIX, H, XB, OUT, lane, 2048 * gidx + 64 * (c >> 3) + 8 * wave, 8, lpost, spost, lpre, spre);
        }
    }
};

__device__ __forceinline__ void rotary_phase(Frame& F) {
    bf16* QKV = (bf16*)(F.ws + WS_BIG); const float* rot = (const float*)(F.ws + WS_ROT);
    const int total = MROWS * 32;
    for (int i = F.gw * 64 + F.lane; i < total; i += F.NGW * 64) {
        const int m = i >> 5, blk = (i >> 1) & 15, hp = i & 1, t = pos_of_row(m);
        bf16* p = QKV + (size_t)m * 6144 + 3072 + blk * 128 + 8 * hp;
        const v4u a = *(const v4u*)p, b = *(const v4u*)(p + 16);
        const f32x4* rt = (const f32x4*)(rot + (size_t)t * 32 + 16 * hp);
        const f32x4 r0 = rt[0], r1 = rt[1], r2 = rt[2], r3 = rt[3];
        const float cs[8] = {r0[0], r0[2], r1[0], r1[2], r2[0], r2[2], r3[0], r3[2]}, sn[8] = {r0[1], r0[3], r1[1], r1[3], r2[1], r2[3], r3[1], r3[3]};
        float x1[8], x2[8], y1[8], y2[8];
#pragma unroll
        for (int e = 0; e < 4; ++e) { x1[2 * e] = bf_lo(a[e]); x1[2 * e + 1] = bf_hi(a[e]); x2[2 * e] = bf_lo(b[e]); x2[2 * e + 1] = bf_hi(b[e]); }
#pragma unroll
        for (int e = 0; e < 8; ++e) { y1[e] = x1[e] * cs[e] - x2[e] * sn[e]; y2[e] = x2[e] * cs[e] + x1[e] * sn[e]; }
        v4u oa, ob;
#pragma unroll
        for (int e = 0; e < 4; ++e) { oa[e] = pk2(y1[2 * e], y1[2 * e + 1]); ob[e] = pk2(y2[2 * e], y2[2 * e + 1]); }
        *(v4u*)p = oa; *(v4u*)(p + 16) = ob;
    }
}

__device__ __forceinline__ void subln_phase(Frame& F, const Args& KA, int j, float one_minus_li) {
    const float* DIFFO = (const float*)(F.ws + WS_MIX); bf16* ATT = ATTBUF(F);
    const float* g = inptr(16) + j * 256;
    const f32x4 gv = *(const f32x4*)(g + 4 * F.lane);
    for (int m = F.gw; m < MROWS; m += F.NGW) {
        f32x4 v[4];
#pragma unroll
        for (int hh = 0; hh < 4; ++hh) v[hh] = *(const f32x4*)(DIFFO + (size_t)m * 1024 + 256 * hh + 4 * F.lane);
#pragma unroll
        for (int hh = 0; hh < 4; ++hh) {
            float ss = (v[hh][0] * v[hh][0] + v[hh][1] * v[hh][1]) + (v[hh][2] * v[hh][2] + v[hh][3] * v[hh][3]);
            ss = wave_sum(ss); const float r = __builtin_amdgcn_rsqf(ss * (1.0f / 256.0f) + NORM_EPS) * one_minus_li;
            v2u w; w.x = pk2(v[hh][0] * r * gv[0], v[hh][1] * r * gv[1]); w.y = pk2(v[hh][2] * r * gv[2], v[hh][3] * r * gv[3]);
            *(v2u*)(ATT + (size_t)m * DM + 1024 + 256 * hh + 4 * F.lane) = w;
        }
    }
}

__device__ __forceinline__ void attention_phase(Frame& F, const Args& KA, int j, float lambda_init) {
    const bf16* QKV = (const bf16*)(F.ws + WS_BIG); bf16* ATT = ATTBUF(F); float* DIFFO = (float*)(F.ws + WS_MIX);
    float lam;
    { const float* lp = inptr(15) + j * 512; const int l = F.lane;
      float s1 = lp[l] * lp[128 + l] + lp[64 + l] * lp[192 + l], s2 = lp[256 + l] * lp[384 + l] + lp[320 + l] * lp[448 + l];
      s1 = wave_sum(s1); s2 = wave_sum(s2); lam = __expf(s1) - __expf(s2) + lambda_init; lam = __uint_as_float(__builtin_amdgcn_readfirstlane(__float_as_uint(lam))); }
#ifndef NO_DIFF
#if MERGED_V
#pragma unroll 1
    for (int u = F.vcu; u < 768; u += F.G) {
        int sh, qb, rb, T;
        if (u < 512) { sh = u >> 6; qb = u & 63; rb = (sh >> 2) * T_PROMPT; T = T_PROMPT; }
        else { const int su = u - 512; sh = su >> 3; qb = su & 7; rb = ROWS_PROMPT + (sh >> 2) * T_SAMPLE; T = T_SAMPLE; }
#if ATT16
        at::diff_unit16(QKV, DIFFO, j, rb, T, sh & 3, qb, lam, F.ldsg, F.lds, F.tid);
#else
        at::diff_unit2(QKV, DIFFO, rb, T, sh & 3, qb, lam, F.ldsg, F.lds, F.tid);
#endif
    }
#else
#pragma unroll 1
    for (int u = F.vcu; u < 1536; u += F.G) {
        int combo, qb, rb, T;
        if (u < 1024) { combo = u >> 6; qb = u & 63; rb = (combo >> 3) * T_PROMPT; T = T_PROMPT; }
        else { const int su = u - 1024; combo = su >> 3; qb = su & 7; rb = ROWS_PROMPT + (combo >> 3) * T_SAMPLE; T = T_SAMPLE; }
        at::diff_unit(QKV, DIFFO, rb, T, (combo >> 1) & 3, qb, combo & 1, lam, F.ldsg, F.tid);
    }
#endif
#endif
#ifndef NO_NA
    { const int per = (1536 + F.G - 1) / F.G; int tid_na = F.tid; asm volatile("" : "+v"(tid_na));
      for (int i = 0; i < per; ++i) { const int nu = F.vcu * per + i; if (nu >= 1536) break;
          const int h = nu / 192, bg = nu % 192; int rb, rows, band;
          if (bg < 128) { rb = (bg >> 6) * T_PROMPT; rows = T_PROMPT / 64; band = bg & 63; } else { const int bs = bg - 128; rb = ROWS_PROMPT + (bs >> 3) * T_SAMPLE; rows = T_SAMPLE / 64; band = bs & 7; }
          at::na_unit(QKV, ATT, inptr(14) + ((size_t)j * 8 + h) * 465, rb, rows, h, band, F.ldsg, tid_na); } }
#endif
}

typedef float s5f2 __attribute__((ext_vector_type(2)));
__device__ __forceinline__ void s5_st_nt(float2* p, float a, float b) { const s5f2 v = {a, b}; __builtin_nontemporal_store(v, (s5f2*)p); }
__device__ __forceinline__ float2 s5_ld_nt(const float2* p) { const s5f2 v = __builtin_nontemporal_load((const s5f2*)p); return make_float2(v[0], v[1]); }
struct S5Lam { float lr, li, cr, ci; };
__device__ __forceinline__ S5Lam s5_lambda(const Args& KA, int j, int dir, int g, int p) {
    const int gi = (j * 2 + dir) * 128 + g;
    const float are = inptr(17)[gi * 64 + p], aim = inptr(18)[gi * 64 + p], dt = __expf(inptr(19)[gi]);
    const float xr = are * dt, th = aim * dt;
    const float ex = __expf(xr), em1 = expm1f(xr), sn = sinf(th), cs = cosf(th), sh = sinf(0.5f * th);
    S5Lam L; L.lr = ex * cs; L.li = ex * sn;
    const float nr = em1 * cs - 2.0f * sh * sh, ni = L.li;
    const float den = 1.0f / (are * are + aim * aim);
    L.cr = (nr * are + ni * aim) * den; L.ci = (ni * are - nr * aim) * den;
    return L;
}
__device__ __forceinline__ void s5_tables(Frame& F, const Args& KA) {
    f32x4* LAM = (f32x4*)(F.ws + WS_S5LAM); float2* L64 = (float2*)(F.ws + WS_S5L64); bf16* BOP = (bf16*)(F.ws + WS_S5BOP); bf16* COP = (bf16*)(F.ws + WS_S5COP);
    for (int combo = F.gw; combo < 512; combo += F.NGW) {
        const int p = F.lane, j = combo >> 8, dir = (combo >> 7) & 1, g = combo & 127;
        const S5Lam L = s5_lambda(KA, j, dir, g, p);
        LAM[combo * 64 + p] = (f32x4){L.lr, L.li, L.cr, L.ci};
        float pr = L.lr, pi = L.li;
#pragma unroll
        for (int i = 0; i < 6; ++i) { const float nr = pr * pr - pi * pi, ni = 2.0f * pr * pi; pr = nr; pi = ni; }
        L64[combo * 64 + p] = make_float2(pr, pi);
        const size_t bo = ((size_t)combo * 64 + p) * 16;
        v4u wr[2], wi[2];
#pragma unroll
        for (int h8 = 0; h8 < 2; ++h8) {
            const f32x4 br0 = *(const f32x4*)(inptr(20) + bo + 8 * h8), br1 = *(const f32x4*)(inptr(20) + bo + 8 * h8 + 4), bi0 = *(const f32x4*)(inptr(21) + bo + 8 * h8), bi1 = *(const f32x4*)(inptr(21) + bo + 8 * h8 + 4);
            wr[h8].x = pk2(L.cr * br0[0] - L.ci * bi0[0], L.cr * br0[1] - L.ci * bi0[1]); wr[h8].y = pk2(L.cr * br0[2] - L.ci * bi0[2], L.cr * br0[3] - L.ci * bi0[3]);
            wr[h8].z = pk2(L.cr * br1[0] - L.ci * bi1[0], L.cr * br1[1] - L.ci * bi1[1]); wr[h8].w = pk2(L.cr * br1[2] - L.ci * bi1[2], L.cr * br1[3] - L.ci * bi1[3]);
            wi[h8].x = pk2(L.cr * bi0[0] + L.ci * br0[0], L.cr * bi0[1] + L.ci * br0[1]); wi[h8].y = pk2(L.cr * bi0[2] + L.ci * br0[2], L.cr * bi0[3] + L.ci * br0[3]);
            wi[h8].z = pk2(L.cr * bi1[0] + L.ci * br1[0], L.cr * bi1[1] + L.ci * br1[1]); wi[h8].w = pk2(L.cr * bi1[2] + L.ci * br1[2], L.cr * bi1[3] + L.ci * br1[3]);
        }
        v4u* bre = (v4u*)(BOP + (((size_t)combo * 2 + 0) * 64 + p) * 16); v4u* bim = (v4u*)(BOP + (((size_t)combo * 2 + 1) * 64 + p) * 16);
        bre[0] = wr[0]; bre[1] = wr[1]; bim[0] = wi[0]; bim[1] = wi[1];
        { const int c = p >> 2, p0 = 16 * (p & 3); const size_t co = ((size_t)combo * 16 + c) * 64 + p0;
          v4u* dst = (v4u*)(COP + ((size_t)combo * 16 + c) * 128 + 2 * p0);
#pragma unroll
          for (int q4 = 0; q4 < 4; ++q4) { const f32x4 cr4 = *(const f32x4*)(inptr(22) + co + 4 * q4), ci4 = *(const f32x4*)(inptr(23) + co + 4 * q4);
              v4u w; w.x = pk2(cr4[0], -ci4[0]); w.y = pk2(cr4[1], -ci4[1]); w.z = pk2(cr4[2], -ci4[2]); w.w = pk2(cr4[3], -ci4[3]); dst[q4] = w; } }
    }
}
struct S5L2 { float lr, li; };
__device__ __forceinline__ S5L2 s5_lam_ld(const Frame& F, int combo, int p) { const f32x4 v = ((const f32x4*)(F.ws + WS_S5LAM))[combo * 64 + p]; S5L2 L; L.lr = v[0]; L.li = v[1]; return L; }
__device__ __forceinline__ void s5_bop_ld(const Frame& F, int combo, int p, int hi, bf16x8& re, bf16x8& im) {
    const bf16* B = (const bf16*)(F.ws + WS_S5BOP);
    re = *(const bf16x8*)(B + (((size_t)combo * 2 + 0) * 64 + p) * 16 + 8 * hi); im = *(const bf16x8*)(B + (((size_t)combo * 2 + 1) * 64 + p) * 16 + 8 * hi);
}
#define S5_PIN(v) asm volatile("" : "+v"(v))
#define S5_STEP(xr, xi, L, br, bi) do { float _t1 = fmaf(-L.li, xi, br); S5_PIN(_t1); float _nr = fmaf(L.lr, xr, _t1); S5_PIN(_nr); float _t2 = fmaf(L.li, xr, bi); S5_PIN(_t2); float _ni = fmaf(L.lr, xi, _t2); S5_PIN(_ni); xr = _nr; xi = _ni; } while (0)

__device__ __forceinline__ void s5_phaseA(Frame& F, const Args& KA, int j) {
    const bf16* H = HBUF(F); float2* E = (float2*)(F.ws + WS_S5E);
    const int r32 = F.lane & 31, hi = F.lane >> 5;
    const int half_i = (r32 >> 2) & 1, r_i = (r32 & 3) + 4 * (r32 >> 3);
    int prev_pair = -1; S5L2 L0, L1; bf16x8 Bop[4];
    L0.lr = L0.li = 0.f; L1 = L0;
#pragma unroll
    for (int k = 0; k < 4; ++k) Bop[k] = (bf16x8){0, 0, 0, 0, 0, 0, 0, 0};
    for (int tk = F.gw; tk < 256 * (S5_NCH / 2); tk += F.NGW) {
        const int pair = tk & 255, q = tk >> 8, g = pair >> 1, dir = pair & 1;
        if (pair != prev_pair) { prev_pair = pair; const int combo = (j * 2 + dir) * 128 + g; L0 = s5_lam_ld(F, combo, r32); L1 = s5_lam_ld(F, combo, 32 + r32);
            s5_bop_ld(F, combo, r32, hi, Bop[0], Bop[1]); s5_bop_ld(F, combo, 32 + r32, hi, Bop[2], Bop[3]); }
        float x0r = 0.f, x0i = 0.f, x1r = 0.f, x1i = 0.f;
        const int tt = dir ? 15 - r_i : r_i;
        const bf16* hp = H + (size_t)(64 * (2 * q + half_i) + tt) * DM + 16 * g + 8 * hi;
        bf16x8 a[4];
#pragma unroll
        for (int bb = 0; bb < 4; ++bb) { const int b = dir ? 3 - bb : bb; a[bb] = *(const bf16x8*)(hp + (size_t)(16 * b) * DM); }
#pragma unroll
        for (int bb = 0; bb < 4; ++bb) {
            f32x16 d0 = __builtin_amdgcn_mfma_f32_32x32x16_bf16(a[bb], Bop[0], (f32x16){}, 0, 0, 0), d1 = __builtin_amdgcn_mfma_f32_32x32x16_bf16(a[bb], Bop[1], (f32x16){}, 0, 0, 0);
            f32x16 d2 = __builtin_amdgcn_mfma_f32_32x32x16_bf16(a[bb], Bop[2], (f32x16){}, 0, 0, 0), d3 = __builtin_amdgcn_mfma_f32_32x32x16_bf16(a[bb], Bop[3], (f32x16){}, 0, 0, 0);
#pragma unroll
            for (int r = 0; r < 16; ++r) { S5_STEP(x0r, x0i, L0, d0[r], d1[r]); S5_STEP(x1r, x1i, L1, d2[r], d3[r]); }
        }
        float2* e = E + ((size_t)((dir * 128 + g) * S5_NCH) + 2 * q + hi) * 64;
        s5_st_nt(e + r32, x0r, x0i); s5_st_nt(e + 32 + r32, x1r, x1i);
    }
}

__device__ __forceinline__ void s5_carry_task(Frame& F, const Args& KA, int j, int tk) {
    const float2* E = (const float2*)(F.ws + WS_S5E); float2* X = (float2*)(F.ws + WS_S5X);
    int dg, c0, nc;
    if (tk < 512) { dg = tk & 255; c0 = (tk >> 8) * (T_PROMPT / S5_L); nc = T_PROMPT / S5_L; }
    else { const int t2 = tk - 512; dg = t2 & 255; c0 = ROWS_PROMPT / S5_L + (t2 >> 8) * (T_SAMPLE / S5_L); nc = T_SAMPLE / S5_L; }
    const int dir = dg >> 7, g = dg & 127, p = F.lane;
    const float2 l64 = ((const float2*)(F.ws + WS_S5L64))[((j * 2 + dir) * 128 + g) * 64 + p]; const float pr = l64.x, pi = l64.y;
    const size_t base = (size_t)dg * S5_NCH * 64 + p;
    float cr = 0.f, ci = 0.f;
    for (int k0 = 0; k0 < nc; k0 += 32) {
        float2 e[32];
#pragma unroll
        for (int i = 0; i < 32; ++i) { const int c = dir ? (c0 + nc - 1 - (k0 + i)) : (c0 + k0 + i); e[i] = s5_ld_nt(E + base + (size_t)c * 64); }
#pragma unroll
        for (int i = 0; i < 32; ++i) { const int c = dir ? (c0 + nc - 1 - (k0 + i)) : (c0 + k0 + i); s5_st_nt(X + base + (size_t)c * 64, cr, ci);
            const float nr = fmaf(pr, cr, fmaf(-pi, ci, e[i].x)), ni = fmaf(pr, ci, fmaf(pi, cr, e[i].y)); cr = nr; ci = ni; }
    }
}
__device__ __forceinline__ void s5_phaseB(Frame& F, const Args& KA, int j) {
    const int gw = F.gw;
#pragma unroll 1
    for (int i = 0; i < 2; ++i) {
        int tk;
        if (F.NGW >= 2048) { if (i == 0) tk = gw; else tk = (gw >= 512 && gw < 1024) ? 2048 + (gw - 512) : -1; if (gw >= 2048) tk = -1; }
        else tk = -2;
        if (tk >= 0) s5_carry_task(F, KA, j, tk);
        if (tk == -2) { if (i == 0) for (int t2 = gw; t2 < 2560; t2 += F.NGW) s5_carry_task(F, KA, j, t2); }
    }
}

template <int DIR> __device__ __forceinline__ void s5c_dir(Frame& F, const Args& KA, int j, int g, int q, LAS unsigned char* tile, f32x16 (&Y)[4]) {
    const bf16* H = HBUF(F); const float2* X = (const float2*)(F.ws + WS_S5X);
    const int r32 = F.lane & 31, hi = F.lane >> 5;
    const int half_i = (r32 >> 2) & 1, r_i = (r32 & 3) + 4 * (r32 >> 3);
    const int combo = (j * 2 + DIR) * 128 + g;
    const S5L2 L0 = s5_lam_ld(F, combo, r32), L1 = s5_lam_ld(F, combo, 32 + r32);
    bf16x8 Bop[4]; s5_bop_ld(F, combo, r32, hi, Bop[0], Bop[1]); s5_bop_ld(F, combo, 32 + r32, hi, Bop[2], Bop[3]);
    LAS unsigned char* cop = tile + 8704;
    if (r32 < 16) {
        const v4u* csrc = (const v4u*)((const bf16*)(F.ws + WS_S5COP) + ((size_t)combo * 16 + r32) * 128 + 8 * hi);
#pragma unroll
        for (int ks = 0; ks < 8; ++ks) *(LAS v4u*)(cop + (ks * 32 + hi * 16 + r32) * 16) = csrc[2 * ks];
    }
    LDS_WAIT();
    const bf16* hp = H + (size_t)(64 * (2 * q + half_i) + r_i) * DM + 16 * g + 8 * hi;
    if (DIR == 0) {
        bf16x8 Dhi = (bf16x8){0, 0, 0, 0, 0, 0, 0, 0}, Dlo = Dhi;
        const float d = (r32 < 16) ? inptr(24)[j * DM + 16 * g + r32] : 0.f;
        const unsigned dh = pk2(d, 0.f) & 0xffffu; const float dhf = __uint_as_float(dh << 16); const unsigned dl = pk2(d - dhf, 0.f) & 0xffffu;
#pragma unroll
        for (int e = 0; e < 8; ++e) { const bool on = (8 * hi + e) == r32; Dhi[e] = on ? (short)dh : (short)0; Dlo[e] = on ? (short)dl : (short)0; }
#pragma unroll
        for (int b = 0; b < 4; ++b) { const bf16x8 ab = *(const bf16x8*)(hp + (size_t)(16 * b) * DM);
            Y[b] = __builtin_amdgcn_mfma_f32_32x32x16_bf16(ab, Dhi, Y[b], 0, 0, 0); Y[b] = __builtin_amdgcn_mfma_f32_32x32x16_bf16(ab, Dlo, Y[b], 0, 0, 0); }
        asm volatile("" ::: "memory");
    }
    float x0r, x0i, x1r, x1i;
    { const float2* xp = X + ((size_t)((DIR * 128 + g) * S5_NCH) + 2 * q + hi) * 64; const float2 a = s5_ld_nt(xp + r32), b = s5_ld_nt(xp + 32 + r32); x0r = a.x; x0i = a.y; x1r = b.x; x1i = b.y; }
    bf16x8 an = *(const bf16x8*)(hp + (size_t)(16 * (DIR ? 3 : 0)) * DM);
#pragma unroll
    for (int bb = 0; bb < 4; ++bb) {
        const int b = DIR ? 3 - bb : bb;
        bf16x8 a[4]; a[b] = an; if (bb < 3) an = *(const bf16x8*)(hp + (size_t)(16 * (DIR ? 2 - bb : bb + 1)) * DM);
        f32x16 d0 = __builtin_amdgcn_mfma_f32_32x32x16_bf16(a[b], Bop[0], (f32x16){}, 0, 0, 0), d1 = __builtin_amdgcn_mfma_f32_32x32x16_bf16(a[b], Bop[1], (f32x16){}, 0, 0, 0);
        f32x16 d2 = __builtin_amdgcn_mfma_f32_32x32x16_bf16(a[b], Bop[2], (f32x16){}, 0, 0, 0), d3 = __builtin_amdgcn_mfma_f32_32x32x16_bf16(a[b], Bop[3], (f32x16){}, 0, 0, 0);
#pragma unroll
        for (int rr = 0; rr < 16; ++rr) { const int r = DIR ? 15 - rr : rr;
            S5_STEP(x0r, x0i, L0, d0[r], d1[r]); S5_STEP(x1r, x1i, L1, d2[r], d3[r]);
            const int row = (r & 3) + 8 * (r >> 2) + 4 * hi;
            *(LAS unsigned*)(tile + row * 272 + 4 * r32) = pk2(x0r, x0i);
            *(LAS unsigned*)(tile + row * 272 + 128 + 4 * r32) = pk2(x1r, x1i); }
        LDS_WAIT();
#pragma unroll
        for (int ks = 0; ks < 8; ++ks) { const bf16x8 xa = *(const LAS bf16x8*)(tile + r32 * 272 + (16 * ks + 8 * hi) * 2);
            v4u cw = *(const LAS v4u*)(cop + (ks * 32 + hi * 16 + (r32 & 15)) * 16); if (r32 >= 16) cw = (v4u){0u, 0u, 0u, 0u};
            Y[b] = __builtin_amdgcn_mfma_f32_32x32x16_bf16(xa, __builtin_bit_cast(bf16x8, cw), Y[b], 0, 0, 0); }
        LDS_WAIT();
    }
}

__device__ __forceinline__ void s5_phaseC(Frame& F, const Args& KA, int j) {
    bf16* ATT = ATTBUF(F);
    LAS unsigned char* tile = F.lds + F.wave * 12800;
    const int r32 = F.lane & 31, hi = F.lane >> 5;
    for (int tk = F.gw; tk < 128 * (S5_NCH / 2); tk += F.NGW) {
        const int g = tk & 127, q = tk >> 7;
        f32x16 Y[4];
#pragma unroll
        for (int b = 0; b < 4; ++b) Y[b] = (f32x16){};
        s5c_dir<0>(F, KA, j, g, q, tile, Y);
        s5c_dir<1>(F, KA, j, g, q, tile, Y);
        if (r32 < 16) {
            bf16* op = ATT + (size_t)(64 * (2 * q + hi)) * DM + 16 * g + r32;
#pragma unroll
            for (int b = 0; b < 4; ++b)
#pragma unroll
                for (int r = 0; r < 16; ++r) { const float x = Y[b][r]; const float z = 0.7978845608028654f * (x + 0.044715f * x * x * x);
                    const float y = x * __builtin_amdgcn_rcpf(1.0f + __builtin_amdgcn_exp2f(-2.8853900817779268f * z));
                    op[(size_t)(16 * b + r) * DM] = (bf16)(pk2(y, 0.f) & 0xffffu); }
        }
    }
}

#ifndef MK_PER_PHASE
#define MK_PER_PHASE 0
#endif
#ifndef EN_ALL
#define EN_ALL 1
#endif
#ifndef EN_P0
#define EN_P0 EN_ALL
#endif
#ifndef EN_NORM
#define EN_NORM EN_ALL
#endif
#ifndef EN_GEMM
#define EN_GEMM EN_ALL
#endif
#ifndef EN_ROT
#define EN_ROT EN_ALL
#endif
#ifndef EN_ATT
#define EN_ATT EN_ALL
#endif
#ifndef EN_SUB
#define EN_SUB EN_ALL
#endif
#ifndef EN_S5A
#define EN_S5A EN_ALL
#endif
#ifndef EN_S5B
#define EN_S5B EN_ALL
#endif
#ifndef EN_S5C
#define EN_S5C EN_ALL
#endif
#ifndef FUSE_NORM
#define FUSE_NORM 0
#endif
constexpr int PH_PER_LAYER = 9, N_PHASES = 2 + NLAYER * PH_PER_LAYER;

__global__ void __launch_bounds__(NWAVES * 64, 2) trunk_fwd(Args args) {
    extern __shared__ __attribute__((aligned(16))) unsigned char lds[];
    Frame F;
    F.lds = (LAS unsigned char*)lds; F.ldsg = (char*)lds;
    F.wave = __builtin_amdgcn_readfirstlane((int)threadIdx.x >> 6); F.lane = (int)xb_lane(); F.tid = F.wave * 64 + F.lane;
    F.G = gridDim.x; { const int bx = blockIdx.x; F.vcu = (F.G % 8 == 0) ? (bx % 8) * (F.G / 8) + bx / 8 : bx; }
    F.gw = blockIdx.x * NWAVES + F.wave; F.NGW = F.G * NWAVES;
    F.out = args.out; F.ws = args.ws;
    volatile LAS unsigned* MISC = (volatile LAS unsigned*)(F.lds + MISC_OFF);
    for (int u = F.tid; u < (LDS_BYTES - LDSCTL_OFF) / 4; u += NWAVES * 64) ((LAS unsigned*)(F.lds + LDSCTL_OFF))[u] = 0u;
    __syncthreads();
    const int lo = args.ph_lo, hi = args.ph_hi;
    XcdBarrier bar; bar.wave = (unsigned)F.wave; bar.bar = (unsigned*)(F.ws + WS_CTL) + CW_BAR; bar.x = 0; bar.st = nullptr;
    if (!MK_PER_PHASE || hi - lo > 1) bar = xcd_barrier_post((unsigned*)(F.ws + WS_CTL) + CW_BAR, MISC + 8, (unsigned)F.wave);
#define REFRESH() do { int _t = (int)xb_lane(); asm volatile("" : "+v"(_t)); F.lane = _t; F.tid = F.wave * 64 + _t; unsigned _l = 0; asm volatile("" : "+s"(_l)); F.ws = args.ws + _l; F.out = args.out + _l; \
    F.lds = (LAS unsigned char*)lds + _l; F.ldsg = (char*)lds + _l; } while (0)
#ifndef HREP_P0
#define HREP_P0 1
#endif
#ifndef HREP_P1
#define HREP_P1 1
#endif
#ifndef HREP_FIN
#define HREP_FIN 1
#endif
#ifndef HREP_FOUT
#define HREP_FOUT 1
#endif
#ifndef HREP_INP
#define HREP_INP 1
#endif
#ifndef HREP_OUTP
#define HREP_OUTP 1
#endif
#ifndef HREP_GLU
#define HREP_GLU 1
#endif
#ifndef HREP_ATT
#define HREP_ATT 1
#endif
#ifndef HREP_S5
#define HREP_S5 1
#endif
#ifndef REP_GEMM
#define REP_GEMM 1
#endif
#ifndef REP_ATT
#define REP_ATT 1
#endif
#ifndef REP_S5
#define REP_S5 1
#endif
#ifndef REP_P0
#define REP_P0 1
#endif
#ifndef REP_SMALL
#define REP_SMALL 1
#endif
#define REPEAT(n) _Pragma("unroll 1") for (int rep_ = 0; rep_ < (n); ++rep_)
#ifndef DBG_STOP
#define DBG_STOP 1000
#endif
#ifndef DBG_DUMP
#define DBG_DUMP 0
#endif
#ifndef DBG_FIRST_LAYER
#define DBG_FIRST_LAYER 0
#endif
#if MK_PER_PHASE
#define IN(k) (lo <= (k) && (k) < hi && (k) <= DBG_STOP)
#define SEAM(k) do { if (lo <= (k) && (k) + 1 < hi) xcd_barrier(bar); } while (0)
#define SEAM2(k) do { if (lo <= (k) && (k) + 2 < hi) xcd_barrier(bar); } while (0)
#else
#define IN(k) ((k) <= DBG_STOP)
#define SEAM(k) xcd_barrier(bar)
#define SEAM2(k) xcd_barrier(bar)
#endif
#define MK_NORM_ORDER(S, MODE_, bank, lpost_, spost_, lpre_, spre_) NormOrder<MODE_> S; S.init(MROWS, DM == 0 ? 0 : S_N, F.G, (int)blockIdx.x); \
    S.cnt = (unsigned*)(args.ws + WS_CTL) + CW_NORM + (bank) * NORM_BANK; S.flag = MISC + 16; S.ADA = (const float*)(F.ws + WS_ADA); S.MIX = (const bf16*)(F.ws + WS_MIX); S.H = HBUF(F); S.XB = XBUF(F); S.OUT = F.out; \
    S.lpost = (lpost_); S.spost = (spost_); S.lpre = (lpre_); S.spre = (spre_); S.wave = F.wave; S.lane = F.lane
#define OUTP(eoff) ({ unsigned _z = 0; asm volatile("" : "+s"(_z)); (bf16*)args.out + _z + (size_t)(eoff); })
#define WSP(off) ({ unsigned _z = 0; asm volatile("" : "+s"(_z)); (bf16*)(args.ws + _z + (off)); })

    if (EN_P0 && IN(0)) { REFRESH(); p0_prologue(F, args); s5_tables(F, args); } SEAM(0);
    if (EN_NORM && IN(1)) { REFRESH(); norm_phase<0>(F, args, 0, 0, 0, 0); } SEAM(1);
#pragma unroll 1
    for (int li = DBG_FIRST_LAYER; li < NLAYER; ++li) {
        const int base = 2 + li * PH_PER_LAYER, j = li >> 1;
        if ((li & 1) == 0) {
            if (EN_GEMM && IN(base + 0)) { REFRESH();
                pg8::Gemm g{OUTP(0), WSP(WS_W_AIN) + (size_t)j * 6144 * DM, MROWS, 6144, DM}; pg8::StaticOrder S; S.init(MROWS, 6144, F.G, (int)blockIdx.x);
                pg8::EpiPlain<false> E{WSP(WS_BIG), 6144};
                pg8::gemm_phase<pg8::EpiPlain<false>, pg8::StaticOrder, true, true>(F.lds, g, S, E, F.tid);
            } SEAM(base + 0);
            if (EN_ROT && IN(base + 1)) { REFRESH(); rotary_phase(F); } SEAM(base + 1);
            if (EN_ATT && IN(base + 2)) { REFRESH(); attention_phase(F, args, j, li == 0 ? 0.2f : 0.4707130183435842f); } SEAM(base + 2);
            if (EN_SUB && !(ATT16 && ATT16_SUBLN) && IN(base + 3)) { REFRESH(); subln_phase(F, args, j, li == 0 ? 0.8f : 0.5292869816564158f); }
#if !(ATT16 && ATT16_SUBLN) || MK_PER_PHASE
            SEAM(base + 3);
#endif
            if (EN_GEMM && IN(base + 4)) { REFRESH();
                pg8::Gemm g{OUTP((size_t)MROWS * DM), WSP(WS_W_AOUT) + (size_t)j * DM * DM, MROWS, DM, DM};
#if FUSE_NORM
                constexpr int S_N = DM; MK_NORM_ORDER(S, 1, li * 2, li, 0, li, 1);
                pg8::EpiPlain<true> E{WSP(WS_MIX), DM};
                pg8::gemm_phase<pg8::EpiPlain<true>, NormOrder<1>, true, true>(F.lds, g, S, E, F.tid);
#else
                pg8::StaticOrder S; S.init(MROWS, DM, F.G, (int)blockIdx.x);
                pg8::EpiPlain<false> E{WSP(WS_MIX), DM};
                pg8::gemm_phase<pg8::EpiPlain<false>, pg8::StaticOrder, true, true>(F.lds, g, S, E, F.tid);
#endif
            } SEAM(base + 4);
        } else {
            if (EN_S5A && IN(base + 0)) { REFRESH(); s5_phaseA(F, args, j); } SEAM(base + 0);
            if (EN_S5B && IN(base + 1)) { REFRESH(); s5_phaseB(F, args, j); } SEAM(base + 1);
            if (EN_S5C && IN(base + 2)) { REFRESH(); s5_phaseC(F, args, j); }
            SEAM2(base + 2);
            if (EN_GEMM && IN(base + 4)) { REFRESH();
                pg8::Gemm g{OUTP((size_t)MROWS * DM), WSP(WS_W_GLU) + (size_t)j * 4096 * DM, MROWS, 4096, DM};
#if FUSE_NORM
                constexpr int S_N = 4096; MK_NORM_ORDER(S, 1, li * 2, li, 0, li, 1);
                pg8::EpiGated<1, true> E{WSP(WS_MIX), DM};
                pg8::gemm_phase<pg8::EpiGated<1, true>, NormOrder<1>, true, true>(F.lds, g, S, E, F.tid);
#else
                pg8::StaticOrder S; S.init(MROWS, 4096, F.G, (int)blockIdx.x);
                pg8::EpiGated<1, false> E{WSP(WS_MIX), DM};
                pg8::gemm_phase<pg8::EpiGated<1, false>, pg8::StaticOrder, true, true>(F.lds, g, S, E, F.tid);
#endif
            } SEAM(base + 4);
        }
#if !FUSE_NORM
        if (EN_NORM && IN(base + 5)) { REFRESH(); norm_phase<1>(F, args, li, 0, li, 1); } SEAM(base + 5);
#endif
        if (EN_GEMM && IN(base + 6)) { REFRESH();
            pg8::Gemm g{OUTP(0), WSP(WS_W_FIN) + (size_t)li * 2 * FF * DM, MROWS, 2 * FF, DM}; pg8::StaticOrder S; S.init(MROWS, 2 * FF, F.G, (int)blockIdx.x);
            pg8::EpiGated<0> E{WSP(WS_BIG), FF};
            pg8::gemm_phase<pg8::EpiGated<0>, pg8::StaticOrder, true, true>(F.lds, g, S, E, F.tid);
        } SEAM(base + 6);
        if (EN_GEMM && IN(base + 7)) { REFRESH();
            pg8::Gemm g{WSP(WS_BIG), WSP(WS_W_FOUT) + (size_t)li * DM * FF, MROWS, DM, FF};
#if FUSE_NORM
            constexpr int S_N = DM; MK_NORM_ORDER(S, 1, li * 2 + 1, li, 1, (li < NLAYER - 1 ? li + 1 : li), 0);
            pg8::EpiPlain<true> E{WSP(WS_MIX), DM};
            pg8::gemm_phase<pg8::EpiPlain<true>, NormOrder<1>, true, true>(F.lds, g, S, E, F.tid);
#else
            pg8::StaticOrder S; S.init(MROWS, DM, F.G, (int)blockIdx.x);
            pg8::EpiPlain<false> E{WSP(WS_MIX), DM};
            pg8::gemm_phase<pg8::EpiPlain<false>, pg8::StaticOrder, true, true>(F.lds, g, S, E, F.tid);
#endif
        }
#if FUSE_NORM
        if (li < NLAYER - 1) SEAM(base + 7);
#else
        SEAM(base + 7);
        if (EN_NORM && IN(base + 8)) { REFRESH(); if (li < NLAYER - 1) norm_phase<1>(F, args, li, 1, li + 1, 0); else norm_phase<2>(F, args, li, 1, 0, 0); }
        if (li < NLAYER - 1) SEAM(base + 8);
#endif
    }
#if DBG_DUMP
    if (!MK_PER_PHASE || hi == N_PHASES) {
        if (!MK_PER_PHASE || hi - lo > 1) xcd_barrier(bar);
        REFRESH();
        const size_t n = (size_t)MROWS * DM; float* o = args.out;
        for (size_t i = (size_t)F.gw * 64 + F.lane; i < n; i += (size_t)F.NGW * 64) {
            const size_t m = i / DM, c = i % DM; float v = 0.f;
            if (DBG_DUMP == 1) v = bf_lo(HBUF(F)[i]);
            if (DBG_DUMP == 2) v = bf_lo(ATTBUF(F)[i]);
            if (DBG_DUMP == 3) v = bf_lo(((const bf16*)(F.ws + WS_MIX))[i]);
            if (DBG_DUMP == 4) v = bf_lo(((const bf16*)(F.ws + WS_BIG))[m * 6144 + c]);
            if (DBG_DUMP == 5) v = bf_lo(((const bf16*)(F.ws + WS_BIG))[m * 6144 + 2048 + c]);
            if (DBG_DUMP == 6) v = bf_lo(((const bf16*)(F.ws + WS_BIG))[m * 6144 + 4096 + c]);
            if (DBG_DUMP == 7) v = (c < 1024) ? ((const float*)(F.ws + WS_MIX))[m * 1024 + c] : 0.f;
            if (DBG_DUMP == 8) v = bf_lo(((const bf16*)(F.ws + WS_BIG))[m * FF + c]);
            if (DBG_DUMP == 9) v = bf_lo(((const bf16*)(F.ws + WS_BIG))[m * FF + 2048 + c]);
            if (DBG_DUMP == 10) v = (c < 1536) ? bf_lo(((const bf16*)(F.ws + WS_BIG))[m * FF + 4096 + c]) : 0.f;
            if (DBG_DUMP == 11) v = (i < S5_STATE_BYTES / 4) ? ((const float*)(F.ws + WS_S5E))[i] : 0.f;
            if (DBG_DUMP == 12) v = (i < S5_STATE_BYTES / 4) ? ((const float*)(F.ws + WS_S5X))[i] : 0.f;
            if (DBG_DUMP == 13) v = (i < 4 * NSEQ * 12288) ? ((const float*)(F.ws + WS_ADA))[i] : ((i < 4 * NSEQ * 12288 + T_PROMPT * 32) ? ((const float*)(F.ws + WS_ROT))[i - 4 * NSEQ * 12288] : 0.f);
            o[i] = v;
        }
    }
#endif
#undef IN
#undef SEAM
}

extern "C" void kernel_launch(void* const* d_in, const int* in_sizes, int n_in, void* d_out, int out_size, void* d_ws, size_t ws_size, hipStream_t stream) {
    static int grid = 0;
    if (grid == 0) {
        if (n_in != 26 || out_size != MROWS * DM || in_sizes[0] != ROWS_PROMPT * DM || ws_size < WS_END) {
            fprintf(stderr, "kernel_launch: shape mismatch (n_in %d, out %d, in0 %d, ws %zu; need ws >= %zu); nothing launched\n", n_in, out_size, n_in > 0 ? in_sizes[0] : -1, ws_size, (size_t)WS_END); grid = -1; return; }
        int dev = 0, cus = 0;
        if (hipGetDevice(&dev) != hipSuccess || hipDeviceGetAttribute(&cus, hipDeviceAttributeMultiprocessorCount, dev) != hipSuccess) { fprintf(stderr, "kernel_launch: device query failed\n"); grid = -1; return; }
        if (hipFuncSetAttribute((const void*)trunk_fwd, hipFuncAttributeMaxDynamicSharedMemorySize, LDS_BYTES) != hipSuccess) { fprintf(stderr, "kernel_launch: hipFuncSetAttribute failed\n"); grid = -1; return; }
        int per_cu = 0;
        if (hipOccupancyMaxActiveBlocksPerMultiprocessor(&per_cu, (const void*)trunk_fwd, NWAVES * 64, LDS_BYTES) != hipSuccess || per_cu < 1)
            fprintf(stderr, "kernel_launch: note: occupancy query reports %d workgroups per CU\n", per_cu);
        (void)hipGetLastError();
        grid = cus;
        if (FUSE_NORM && grid != 256) { fprintf(stderr, "kernel_launch: this build's fused norm passes need exactly 256 workgroups (one per CU of a 256-CU device); device has %d CUs; nothing launched\n", cus); grid = -1; return; }
    }
    if (grid < 0) return;
    if (hipMemsetAsync((char*)d_ws + WS_CTL, 0, CTL_ZERO_BYTES, stream) != hipSuccess) { fprintf(stderr, "kernel_launch: memset failed\n"); return; }
    Args a{};
    for (int i = 0; i < 26; ++i) a.in[i] = (const float*)d_in[i];
    a.out = (float*)d_out; a.ws = (unsigned char*)d_ws;
#if MK_PER_PHASE
    for (int k = 0; k < N_PHASES; ++k) {
        if (k >= 2) { const int li = (k - 2) / PH_PER_LAYER, kk = (k - 2) % PH_PER_LAYER; if ((li & 1) && kk == 3) continue; if (FUSE_NORM && (kk == 5 || kk == 8)) continue; }
        a.ph_lo = k; a.ph_hi = k + 1;
        int reps = 1;
        if (k == 0) reps = HREP_P0;
        if (k == 1) reps = HREP_P1;
        if (k >= 2) { const int li = (k - 2) / PH_PER_LAYER, kk = (k - 2) % PH_PER_LAYER;
            if (kk == 6) reps = HREP_FIN; if (kk == 7) reps = HREP_FOUT;
            if (!(li & 1)) { if (kk == 0) reps = HREP_INP; if (kk == 2) reps = HREP_ATT; if (kk == 4) reps = HREP_OUTP; }
            else { if (kk <= 2) reps = HREP_S5; if (kk == 4) reps = HREP_GLU; } }
        for (int r = 0; r < reps; ++r) hipLaunchKernelGGL(trunk_fwd, dim3(grid), dim3(NWAVES * 64), LDS_BYTES, stream, a);
    }
#else
    a.ph_lo = 0; a.ph_hi = N_PHASES;
    hipLaunchKernelGGL(trunk_fwd, dim3(grid), dim3(NWAVES * 64), LDS_BYTES, stream, a);
#endif
    const hipError_t le = hipPeekAtLastError();
    if (le != hipSuccess) fprintf(stderr, "kernel_launch: launch failed: %s\n", hipGetErrorName(le));
}
```

```cpp
#ifndef ATT16
#define ATT16 1
#endif
#include <hip/hip_runtime.h>
#include <cstdio>
#include <cstdint>
namespace pg8 {
#define PG8_LAS __attribute__((address_space(3)))
typedef unsigned short bf16_t;
typedef short bf16x8 __attribute__((ext_vector_type(8)));
typedef float f32x4 __attribute__((ext_vector_type(4)));
typedef unsigned u32x4 __attribute__((ext_vector_type(4)));
constexpr int BM = 256, BK = 64, HALF = 128, HTB = HALF * BK * 2  , STAGE_BYTES = 8 * HTB, NXCD = 8, WGM = 8;

__host__ __device__ __forceinline__ int lds_byte(int r, int c) { const int st = (r >> 4) * 2 + (c >> 5), rr = r & 15, cc = c & 31, ob = rr * 64 + cc * 2; return st * 1024 + (ob ^ (((ob >> 9) & 1) << 5)); }
__host__ __device__ __forceinline__ void stage_rc(int b, int& R, int& C) { const int st = b / 1024, sb = b % 1024, swz = sb ^ (((sb >> 9) & 1) << 5); R = (st >> 1) * 16 + swz / 64; C = (st & 1) * 32 + (swz % 64) / 2; }
__host__ __device__ __forceinline__ int perm32(int rho) { const int n = rho >> 4, i = rho & 15; return 8 * (i >> 2) + 4 * n + (i & 3); }

struct Unit { int pm, pn; };
struct Gemm { const bf16_t* A; const bf16_t* Bt; int M, N, K; };

struct StaticOrder {
    int nM, nN, nwg, G, c;
    __host__ __device__ void init(int M, int N, int G_, int c_) { nM = M / BM; nN = N / BM; nwg = nM * nN; G = G_; c = c_; }
    __host__ __device__ bool next(int i, Unit& u) const {
        const long L = (long)i * G + c; if (L >= nwg) return false;
        int wgid = (int)L; { const int q = nwg / NXCD, r = nwg % NXCD, xcd = wgid % NXCD, off = wgid / NXCD; wgid = (xcd < r ? xcd * (q + 1) : r * (q + 1) + (xcd - r) * q) + off; }
        const int nig = WGM * nN, gid = wgid / nig, fm = gid * WGM, gsz = (nM - fm) < WGM ? (nM - fm) : WGM;
        u.pm = fm + ((wgid % nig) % gsz); u.pn = (wgid % nig) / gsz; return true;
    }
    __device__ __forceinline__ void a_ready(const Unit&) const {}
    __device__ __forceinline__ void done(const Unit&) const {}
};

__device__ __forceinline__ unsigned cvt_pk_bf16(float lo, float hi) { typedef __bf16 bfx2_ __attribute__((ext_vector_type(2))); typedef float flx2_ __attribute__((ext_vector_type(2))); const flx2_ v_ = {lo, hi}; return __builtin_bit_cast(unsigned, __builtin_convertvector(v_, bfx2_)); }

template <bool WT> __device__ __forceinline__ void st16(bf16_t* base, size_t elem_off, u32x4 w) {
    if constexpr (WT) { const __amdgpu_buffer_rsrc_t rs = __builtin_amdgcn_make_buffer_rsrc((void*)base, (short)0, 0x7ffffffe, 0x00020000); __builtin_amdgcn_raw_buffer_store_b128(w, rs, (unsigned)(elem_off * 2), 0, 16); }
    else *(u32x4*)(base + elem_off) = w;
}
template <bool WT = false> struct EpiPlain {
    static constexpr bool PERM = true, AFTER_DRAIN = false;
    bf16_t* O; int ldc;
    __device__ __forceinline__ void operator()(const f32x4 (&acc)[2][2][4][2], const Unit& u, int wr, int wc, int fr, int fq) const {
        const int row0 = u.pm * BM + wr * 64 + fr, col0 = u.pn * BM + wc * 32 + 8 * fq;
#pragma unroll
        for (int ai = 0; ai < 2; ++ai)
#pragma unroll
            for (int m = 0; m < 4; ++m) { const size_t ro = (size_t)(row0 + ai * HALF + m * 16) * ldc + col0;
#pragma unroll
                for (int bj = 0; bj < 2; ++bj) { const f32x4 v0 = acc[ai][bj][m][0], v1 = acc[ai][bj][m][1];
                    u32x4 w; w.x = cvt_pk_bf16(v0[0], v0[1]); w.y = cvt_pk_bf16(v0[2], v0[3]); w.z = cvt_pk_bf16(v1[0], v1[1]); w.w = cvt_pk_bf16(v1[2], v1[3]);
                    st16<WT>(O, ro + bj * HALF, w); } }
    }
};
__device__ __forceinline__ float sigm(float x) { return __builtin_amdgcn_rcpf(1.0f + __builtin_amdgcn_exp2f(-1.4426950408889634f * x)); }
template <int ACT, bool WT = false> struct EpiGated {
    static constexpr bool PERM = true, AFTER_DRAIN = false;
    bf16_t* O; int ldc;
    __device__ __forceinline__ float f(float a, float b) const { return ACT == 0 ? a * sigm(a) * b : a * sigm(b); }
    __device__ __forceinline__ void operator()(const f32x4 (&acc)[2][2][4][2], const Unit& u, int wr, int wc, int fr, int fq) const {
        const int row0 = u.pm * BM + wr * 64 + fr, col0 = u.pn * HALF + wc * 32 + 8 * fq;
#pragma unroll
        for (int ai = 0; ai < 2; ++ai)
#pragma unroll
            for (int m = 0; m < 4; ++m) { const size_t ro = (size_t)(row0 + ai * HALF + m * 16) * ldc + col0;
                const f32x4 a0 = acc[ai][0][m][0], a1 = acc[ai][0][m][1], b0 = acc[ai][1][m][0], b1 = acc[ai][1][m][1];
                u32x4 w; w.x = cvt_pk_bf16(f(a0[0], b0[0]), f(a0[1], b0[1])); w.y = cvt_pk_bf16(f(a0[2], b0[2]), f(a0[3], b0[3]));
                w.z = cvt_pk_bf16(f(a1[0], b1[0]), f(a1[1], b1[1])); w.w = cvt_pk_bf16(f(a1[2], b1[2]), f(a1[3], b1[3]));
                st16<WT>(O, ro, w); }
    }
};

template <class Epi, class Sched, bool ALIGN_EPI = false, bool SP2 = false>
__device__ __forceinline__ void gemm_phase(PG8_LAS unsigned char* lds, const Gemm g, const Sched& S, const Epi& E, const int tid_in) {
    const int tid = tid_in, wid = __builtin_amdgcn_readfirstlane(tid >> 6), lane = tid & 63, wr = wid >> 2, wc = wid & 3, fr = lane & 15, fq = lane >> 4;
    const int K = g.K, nt = K / BK;
    unsigned voffA[2], voffB[2];
#pragma unroll
    for (int i = 0; i < 2; ++i) { int R, C; stage_rc(tid * 16 + i * 8192, R, C); const int Rb = Epi::PERM ? ((R & ~31) + perm32(R & 31)) : R;
        voffA[i] = (unsigned)(R * K + C) * 2u; voffB[i] = (unsigned)(Rb * K + C) * 2u; }
    const size_t kstep = (size_t)(BK * 2);
    const size_t hstep = (size_t)HALF * K * 2;
    const size_t tstep = 2 * hstep;
    const unsigned ldsw = (unsigned)wid * 1024u;
    const int aoff = lds_byte(wr * 64 + fr, fq * 8), boff = lds_byte(wc * 32 + fr, fq * 8);
#define PG8_SA(b, h) (((b) * 2 + (h)) * HTB)
#define PG8_SB(b, h) ((4 + (b) * 2 + (h)) * HTB)
#define PG8_STAGE(bufoff, gbase, voff) do { _Pragma("unroll") for (int _i = 0; _i < 2; ++_i) \
        __builtin_amdgcn_global_load_lds((const unsigned*)((const char*)(gbase) + (voff)[_i]), (PG8_LAS unsigned*)(lds + (bufoff) + ldsw + _i * 8192), 16, 0, 0); } while (0)
#define PG8_LDA(dst, b, h) do { _Pragma("unroll") for (int m = 0; m < 4; ++m) _Pragma("unroll") for (int k = 0; k < 2; ++k) dst[m][k] = *(const PG8_LAS bf16x8*)(lds + PG8_SA(b, h) + aoff + m * 2048 + k * 1024); } while (0)
#define PG8_LDB(dst, b, h) do { _Pragma("unroll") for (int n = 0; n < 2; ++n) _Pragma("unroll") for (int k = 0; k < 2; ++k) dst[n][k] = *(const PG8_LAS bf16x8*)(lds + PG8_SB(b, h) + boff + n * 2048 + k * 1024); } while (0)
#define PG8_MMA(ai, bj, At, Bt) do { __builtin_amdgcn_s_setprio(1); _Pragma("unroll") for (int m = 0; m < 4; ++m) _Pragma("unroll") for (int n = 0; n < 2; ++n) _Pragma("unroll") for (int k = 0; k < 2; ++k) \
        acc[ai][bj][m][n] = __builtin_amdgcn_mfma_f32_16x16x32_bf16(Bt[n][k], At[m][k], acc[ai][bj][m][n], 0, 0, 0); __builtin_amdgcn_s_setprio(0); } while (0)
#define PG8_WAIT_V(n) asm volatile("s_waitcnt vmcnt(" #n ")" ::: "memory")
#define PG8_WAIT_L(n) asm volatile("s_waitcnt lgkmcnt(" #n ")" ::: "memory")
#define PG8_BAR __builtin_amdgcn_s_barrier()
#define PG8_SCHED __builtin_amdgcn_sched_barrier(0)
    Unit cur, nxt; int ui = 0;
    if (!S.next(0, cur)) return;
    f32x4 acc[2][2][4][2];
#pragma unroll
    for (int a = 0; a < 2; ++a)
#pragma unroll
        for (int b = 0; b < 2; ++b)
#pragma unroll
            for (int m = 0; m < 4; ++m)
#pragma unroll
                for (int n = 0; n < 2; ++n) acc[a][b][m][n] = (f32x4){0.f, 0.f, 0.f, 0.f};
    bf16x8 At[4][2], B0[2][2], B1[2][2];
    const char* cA = (const char*)g.A + (size_t)cur.pm * tstep; const char* cB = (const char*)g.Bt + (size_t)cur.pn * tstep;
    S.a_ready(cur);
    if constexpr (SP2) {
        PG8_STAGE(PG8_SB(0, 0), cB, voffB); PG8_STAGE(PG8_SB(0, 1), cB + hstep, voffB); PG8_STAGE(PG8_SA(0, 0), cA, voffA); PG8_STAGE(PG8_SA(0, 1), cA + hstep, voffA);
        if (wr == 1) PG8_BAR;
        PG8_WAIT_V(2); PG8_BAR;
        PG8_STAGE(PG8_SB(1, 0), cB + kstep, voffB); PG8_STAGE(PG8_SA(1, 0), cA + kstep, voffA); PG8_STAGE(PG8_SB(1, 1), cB + hstep + kstep, voffB);
        PG8_WAIT_V(6); PG8_BAR;
    } else {
        PG8_STAGE(PG8_SB(0, 0), cB, voffB); PG8_STAGE(PG8_SA(0, 0), cA, voffA); PG8_STAGE(PG8_SB(0, 1), cB + hstep, voffB); PG8_STAGE(PG8_SA(0, 1), cA + hstep, voffA);
        if (wr == 1) PG8_BAR;
        PG8_WAIT_V(4); PG8_BAR;
        PG8_STAGE(PG8_SB(1, 0), cB + kstep, voffB); PG8_STAGE(PG8_SA(1, 0), cA + kstep, voffA); PG8_STAGE(PG8_SB(1, 1), cB + hstep + kstep, voffB);
        PG8_WAIT_V(6); PG8_BAR;
    }
    for (;;) {
        const bool has_next = S.next(ui + 1, nxt);
        const char* nA = has_next ? (const char*)g.A + (size_t)nxt.pm * tstep : cA; const char* nB = has_next ? (const char*)g.Bt + (size_t)nxt.pn * tstep : cB;
        for (int t = 0; t < nt; t += 2) {
            const bool last = (t == nt - 2);
            const char* a1 = cA + (size_t)(t + 1) * kstep;
            const char* a2 = last ? nA : cA + (size_t)(t + 2) * kstep; const char* b2 = last ? nB : cB + (size_t)(t + 2) * kstep;
            const char* a3 = a2 + kstep; const char* b3 = b2 + kstep;
            if (last && has_next) S.a_ready(nxt);
            if constexpr (SP2) {
            PG8_LDB(B0, 0, 0); PG8_LDB(B1, 0, 1); PG8_SCHED; PG8_LDA(At, 0, 0); PG8_STAGE(PG8_SA(1, 1), a1 + hstep, voffA);
            PG8_WAIT_V(8); PG8_WAIT_L(0); PG8_BAR; PG8_MMA(0, 0, At, B0); PG8_MMA(0, 1, At, B1); PG8_BAR; PG8_SCHED;
            PG8_LDA(At, 0, 1); PG8_STAGE(PG8_SB(0, 0), b2, voffB); PG8_STAGE(PG8_SB(0, 1), b2 + hstep, voffB); PG8_STAGE(PG8_SA(0, 0), a2, voffA);
            PG8_WAIT_V(8); PG8_WAIT_L(0); PG8_BAR; PG8_MMA(1, 0, At, B0); PG8_MMA(1, 1, At, B1); PG8_BAR; PG8_SCHED;
            PG8_LDB(B0, 1, 0); PG8_LDB(B1, 1, 1); PG8_SCHED; PG8_LDA(At, 1, 0); PG8_STAGE(PG8_SA(0, 1), a2 + hstep, voffA);
            PG8_WAIT_V(8); PG8_WAIT_L(0); PG8_BAR; PG8_MMA(0, 0, At, B0); PG8_MMA(0, 1, At, B1); PG8_BAR; PG8_SCHED;
            PG8_LDA(At, 1, 1); PG8_STAGE(PG8_SB(1, 0), b3, voffB); PG8_STAGE(PG8_SB(1, 1), b3 + hstep, voffB); PG8_STAGE(PG8_SA(1, 0), a3, voffA);
            PG8_WAIT_V(8); PG8_WAIT_L(0); PG8_BAR; PG8_MMA(1, 0, At, B0); PG8_MMA(1, 1, At, B1); PG8_BAR; PG8_SCHED;
            } else {
            PG8_LDB(B0, 0, 0); PG8_SCHED; PG8_LDA(At, 0, 0); PG8_STAGE(PG8_SA(1, 1), a1 + hstep, voffA);
            PG8_WAIT_L(8); PG8_BAR; PG8_WAIT_L(0); PG8_MMA(0, 0, At, B0); PG8_BAR; PG8_SCHED;
            PG8_LDB(B1, 0, 1); PG8_STAGE(PG8_SB(0, 0), b2, voffB);
            PG8_BAR; PG8_WAIT_L(0); PG8_MMA(0, 1, At, B1); PG8_BAR;
            PG8_LDA(At, 0, 1); PG8_STAGE(PG8_SA(0, 0), a2, voffA);
            PG8_BAR; PG8_WAIT_L(0); PG8_MMA(1, 0, At, B0); PG8_BAR; PG8_SCHED;
            PG8_STAGE(PG8_SB(0, 1), b2 + hstep, voffB);
            PG8_WAIT_V(6); PG8_BAR; PG8_MMA(1, 1, At, B1); PG8_BAR;
            PG8_LDB(B0, 1, 0); PG8_SCHED; PG8_LDA(At, 1, 0); PG8_STAGE(PG8_SA(0, 1), a2 + hstep, voffA);
            PG8_WAIT_L(8); PG8_BAR; PG8_WAIT_L(0); PG8_MMA(0, 0, At, B0); PG8_BAR; PG8_SCHED;
            PG8_LDB(B1, 1, 1); PG8_STAGE(PG8_SB(1, 0), b3, voffB);
            PG8_BAR; PG8_WAIT_L(0); PG8_MMA(0, 1, At, B1); PG8_BAR;
            PG8_LDA(At, 1, 1); PG8_STAGE(PG8_SA(1, 0), a3, voffA);
            PG8_BAR; PG8_WAIT_L(0); PG8_MMA(1, 0, At, B0); PG8_BAR; PG8_SCHED;
            PG8_STAGE(PG8_SB(1, 1), b3 + hstep, voffB);
            PG8_WAIT_V(6); PG8_BAR; PG8_MMA(1, 1, At, B1); PG8_BAR;
            }
        }
        if constexpr (ALIGN_EPI) { if (wr == 0) PG8_BAR; }
        if constexpr (!Epi::AFTER_DRAIN) { E(acc, cur, wr, wc, fr, fq); S.done(cur); }
        if (!has_next) break;
#pragma unroll
        for (int a = 0; a < 2; ++a)
#pragma unroll
            for (int b = 0; b < 2; ++b)
#pragma unroll
                for (int m = 0; m < 4; ++m)
#pragma unroll
                    for (int n = 0; n < 2; ++n) acc[a][b][m][n] = (f32x4){0.f, 0.f, 0.f, 0.f};
        cur = nxt; cA = nA; cB = nB; ++ui;
        if constexpr (ALIGN_EPI) { if (wr == 1) PG8_BAR; }
    }
    PG8_WAIT_V(0);
    if constexpr (!ALIGN_EPI) { if (wr == 0) PG8_BAR; }
    PG8_BAR;
    if constexpr (Epi::AFTER_DRAIN) { E.fused(acc, cur, wr, wc, fr, fq, lds, wid, lane); S.done(cur); }
#undef PG8_SA
#undef PG8_SB
#undef PG8_STAGE
#undef PG8_LDA
#undef PG8_LDB
#undef PG8_MMA
#undef PG8_WAIT_V
#undef PG8_WAIT_L
#undef PG8_BAR
#undef PG8_SCHED
}
}

#define LAS __attribute__((address_space(3)))

namespace at {
typedef unsigned short bf16;
constexpr int   D = 128, NW = 8, QBLK = 32, KVBLK = 64;
constexpr float SCALE = 0.088388347648318440f;
constexpr float THR = 8.f;
constexpr int   LDX = 6144;
constexpr size_t SHM_V = KVBLK * D * 2, SHM_K = KVBLK * D * 2, SHM_ATTN = 2 * SHM_V + 2 * SHM_K + NW * 64 * 4;
constexpr size_t SHM_RPB = SHM_ATTN;
using bf16x8 = __attribute__((ext_vector_type(8))) short;
using s16x4  = __attribute__((ext_vector_type(4))) short;
using f32x16 = __attribute__((ext_vector_type(16))) float;
using u32x4  = __attribute__((ext_vector_type(4))) unsigned;
#define KSWZ(row, colB) ((row) * 256 + ((colB) ^ (((row) & 7) << 4)))
#define SBAR() __builtin_amdgcn_sched_barrier(0)
__device__ __forceinline__ int crow(int r, int hi) { return (r & 3) + 8 * (r >> 2) + 4 * hi; }
__device__ __forceinline__ unsigned cvtpk(float lo, float hi) { typedef __bf16 bfx2_ __attribute__((ext_vector_type(2))); typedef float flx2_ __attribute__((ext_vector_type(2))); const flx2_ v_ = {lo, hi}; return __builtin_bit_cast(unsigned, __builtin_convertvector(v_, bfx2_)); }
__device__ __forceinline__ bf16x8 ld8(const bf16* p) { return *reinterpret_cast<const bf16x8*>(p); }

template <int OFF> __device__ __forceinline__ bf16x8 k_read(int a) { bf16x8 r; asm volatile("ds_read_b128 %0, %1 offset:%2" : "=&v"(r) : "v"(a), "i"(OFF) : "memory"); return r; }
__device__ __forceinline__ void qkt_pipe(f32x16& p0, f32x16& p1, int kaddr, int sw, int h16, const bf16x8* qr) {
  p0 = f32x16{}; p1 = f32x16{};
  bf16x8 a0, a1, b0, b1;
#define KAD(d) (kaddr + ((((d) * 32) + h16) ^ sw))
  { const int ad = KAD(0); a0 = k_read<0>(ad); a1 = k_read<8192>(ad); }
#define QK_STEP(d, C0, C1, N0, N1) do { { const int ad = KAD((d) + 1); N0 = k_read<0>(ad); N1 = k_read<8192>(ad); } asm volatile("s_waitcnt lgkmcnt(2)" ::: "memory"); SBAR(); \
    p0 = __builtin_amdgcn_mfma_f32_32x32x16_bf16(C0, qr[d], p0, 0, 0, 0); p1 = __builtin_amdgcn_mfma_f32_32x32x16_bf16(C1, qr[d], p1, 0, 0, 0); SBAR(); } while (0)
  QK_STEP(0, a0, a1, b0, b1); QK_STEP(1, b0, b1, a0, a1); QK_STEP(2, a0, a1, b0, b1); QK_STEP(3, b0, b1, a0, a1); QK_STEP(4, a0, a1, b0, b1); QK_STEP(5, b0, b1, a0, a1); QK_STEP(6, a0, a1, b0, b1);
  asm volatile("s_waitcnt lgkmcnt(0)" ::: "memory"); SBAR();
  p0 = __builtin_amdgcn_mfma_f32_32x32x16_bf16(b0, qr[7], p0, 0, 0, 0); p1 = __builtin_amdgcn_mfma_f32_32x32x16_bf16(b1, qr[7], p1, 0, 0, 0);
#undef QK_STEP
#undef KAD
}
__device__ __forceinline__ void partialSM(f32x16& p0, f32x16& p1, float& m_reg, float& mn, float& alpha) {
  constexpr float C = SCALE * 1.4426950408889634f;
  float pmax;
  { float c0 = fmaxf(p0[0], p0[1]), c1 = fmaxf(p0[8], p0[9]), c2 = fmaxf(p1[0], p1[1]), c3 = fmaxf(p1[8], p1[9]);
#pragma unroll
    for (int r = 2; r < 8; r += 2) { c0 = fmaxf(fmaxf(c0, p0[r]), p0[r + 1]); c1 = fmaxf(fmaxf(c1, p0[8 + r]), p0[9 + r]); c2 = fmaxf(fmaxf(c2, p1[r]), p1[r + 1]); c3 = fmaxf(fmaxf(c3, p1[8 + r]), p1[9 + r]); }
    pmax = fmaxf(fmaxf(c0, c1), fmaxf(c2, c3)); }
  { auto rr = __builtin_amdgcn_permlane32_swap(__float_as_uint(pmax), __float_as_uint(pmax), false, false);
    pmax = fmaxf(__uint_as_float(rr[0]), __uint_as_float(rr[1])); }
  if (__builtin_expect(__all(pmax - m_reg <= THR / SCALE), 1)) { mn = m_reg; alpha = 1.f; }
  else { mn = fmaxf(m_reg, pmax); alpha = __builtin_amdgcn_exp2f((m_reg - mn) * C); m_reg = mn; }
  float mnC = -mn * C;
#pragma unroll
  for (int r = 0; r < 16; ++r) p0[r] = fmaf(p0[r], C, mnC);
#pragma unroll
  for (int r = 0; r < 16; ++r) p1[r] = fmaf(p1[r], C, mnC);
#pragma unroll
  for (int r = 0; r < 16; ++r) p0[r] = __builtin_amdgcn_exp2f(p0[r]);
}
__device__ __forceinline__ void partialSM2(f32x16& p0, const f32x16& p1, float& m_reg, float& alpha, float& mnC) {
  constexpr float C = SCALE * 1.4426950408889634f;
  float pmax;
  { float c0 = fmaxf(p0[0], p0[1]), c1 = fmaxf(p0[8], p0[9]), c2 = fmaxf(p1[0], p1[1]), c3 = fmaxf(p1[8], p1[9]);
#pragma unroll
    for (int r = 2; r < 8; r += 2) { c0 = fmaxf(fmaxf(c0, p0[r]), p0[r + 1]); c1 = fmaxf(fmaxf(c1, p0[8 + r]), p0[9 + r]); c2 = fmaxf(fmaxf(c2, p1[r]), p1[r + 1]); c3 = fmaxf(fmaxf(c3, p1[8 + r]), p1[9 + r]); }
    pmax = fmaxf(fmaxf(c0, c1), fmaxf(c2, c3)); }
  { auto rr = __builtin_amdgcn_permlane32_swap(__float_as_uint(pmax), __float_as_uint(pmax), false, false);
    pmax = fmaxf(__uint_as_float(rr[0]), __uint_as_float(rr[1])); }
  float mn;
  if (__builtin_expect(__all(pmax - m_reg <= THR / SCALE), 1)) { mn = m_reg; alpha = 1.f; }
  else { mn = fmaxf(m_reg, pmax); alpha = __builtin_amdgcn_exp2f((m_reg - mn) * C); m_reg = mn; }
  mnC = -mn * C;
#pragma unroll
  for (int r = 0; r < 16; ++r) p0[r] = __builtin_amdgcn_exp2f(fmaf(p0[r], C, mnC));
}
__device__ __forceinline__ void finishSM(f32x16& p0, f32x16& p1, float alpha, float& l_reg, bf16x8& pa0, bf16x8& pa1, bf16x8& pa2, bf16x8& pa3) {
#pragma unroll
  for (int r = 0; r < 16; ++r) p1[r] = __builtin_amdgcn_exp2f(p1[r]);
  float ps = 0;
#pragma unroll
  for (int r = 0; r < 16; ++r) ps += p0[r];
#pragma unroll
  for (int r = 0; r < 16; ++r) ps += p1[r];
  { auto rr = __builtin_amdgcn_permlane32_swap(__float_as_uint(ps), __float_as_uint(ps), false, false);
    ps = __uint_as_float(rr[0]) + __uint_as_float(rr[1]); }
  l_reg = l_reg * alpha + ps;
#define PK4(P, BASE, OUT) do { unsigned a0 = cvtpk(P[BASE + 0], P[BASE + 1]), a1 = cvtpk(P[BASE + 2], P[BASE + 3]);   \
    unsigned b0 = cvtpk(P[BASE + 4], P[BASE + 5]), b1 = cvtpk(P[BASE + 6], P[BASE + 7]);                              \
    auto r0 = __builtin_amdgcn_permlane32_swap(a0, b0, false, false); auto r1 = __builtin_amdgcn_permlane32_swap(a1, b1, false, false); \
    u32x4 w = {r0[0], r1[0], r0[1], r1[1]}; OUT = __builtin_bit_cast(bf16x8, w); } while (0)
  PK4(p0, 0, pa0); PK4(p0, 8, pa1); PK4(p1, 0, pa2); PK4(p1, 8, pa3);
#undef PK4
}
__device__ __forceinline__ void qkt(f32x16& p0, f32x16& p1, const bf16* Ks, const bf16x8* qr, int r32, int hi) {
  p0 = f32x16{}; p1 = f32x16{};
#pragma unroll
  for (int d0 = 0; d0 < 8; ++d0) { int cb = (d0 * 16 + hi * 8) * 2;
    bf16x8 b0 = *reinterpret_cast<const bf16x8*>((const char*)Ks + KSWZ(r32, cb));
    bf16x8 b1 = *reinterpret_cast<const bf16x8*>((const char*)Ks + KSWZ(32 + r32, cb));
    p0 = __builtin_amdgcn_mfma_f32_32x32x16_bf16(b0, qr[d0], p0, 0, 0, 0);
    p1 = __builtin_amdgcn_mfma_f32_32x32x16_bf16(b1, qr[d0], p1, 0, 0, 0); }
}
__device__ __forceinline__ int v_st(int k, int c) { const int kk = (k & ~0xC) | ((k & 4) << 1) | ((k & 8) >> 1); return ((kk >> 3) * 4 + (c >> 5)) * 512 + ((kk & 7) * 32 + (c & 31)) * 2; }
__device__ __forceinline__ int v_rd_base(int lane) { return ((lane & 3) << 3) | (((lane >> 2) & 3) << 6) | (((lane >> 4) & 1) << 5) | (((lane >> 5) & 1) << 8); }
constexpr int v_rd_off(int d0, int ks, int half) { return d0 * 512 + ks * 4096 + half * 2048; }
template <int OFF> __device__ __forceinline__ s16x4 tr_read(int vb) {
  s16x4 r; asm volatile("ds_read_b64_tr_b16 %0, %1 offset:%2" : "=&v"(r) : "v"(vb), "i"(OFF) : "memory"); return r;
}
template <int D0> __device__ __forceinline__ void pv_one(f32x16& od, int vb, bf16x8 pa0, bf16x8 pa1, bf16x8 pa2, bf16x8 pa3) {
  const s16x4 l0 = tr_read<v_rd_off(D0, 0, 0)>(vb), h0 = tr_read<v_rd_off(D0, 0, 1)>(vb), l1 = tr_read<v_rd_off(D0, 1, 0)>(vb), h1 = tr_read<v_rd_off(D0, 1, 1)>(vb);
  const s16x4 l2 = tr_read<v_rd_off(D0, 2, 0)>(vb), h2 = tr_read<v_rd_off(D0, 2, 1)>(vb), l3 = tr_read<v_rd_off(D0, 3, 0)>(vb), h3 = tr_read<v_rd_off(D0, 3, 1)>(vb);
  asm volatile("s_waitcnt lgkmcnt(0)" ::: "memory"); SBAR();
#define PK(L, H) (bf16x8){L[0], L[1], L[2], L[3], H[0], H[1], H[2], H[3]}
  od = __builtin_amdgcn_mfma_f32_32x32x16_bf16(pa0, PK(l0, h0), od, 0, 0, 0);
  od = __builtin_amdgcn_mfma_f32_32x32x16_bf16(pa1, PK(l1, h1), od, 0, 0, 0);
  od = __builtin_amdgcn_mfma_f32_32x32x16_bf16(pa2, PK(l2, h2), od, 0, 0, 0);
  od = __builtin_amdgcn_mfma_f32_32x32x16_bf16(pa3, PK(l3, h3), od, 0, 0, 0);
#undef PK
}
__device__ __forceinline__ void pv_d0(f32x16* o, int vb, bf16x8 pa0, bf16x8 pa1, bf16x8 pa2, bf16x8 pa3) {
  pv_one<0>(o[0], vb, pa0, pa1, pa2, pa3); pv_one<1>(o[1], vb, pa0, pa1, pa2, pa3); pv_one<2>(o[2], vb, pa0, pa1, pa2, pa3); pv_one<3>(o[3], vb, pa0, pa1, pa2, pa3);
}

__device__ __forceinline__ void flash_pass(const bf16* __restrict__ Qb, const bf16* __restrict__ Kh, const bf16* __restrict__ Vh, int seq, char* lds, f32x16 (&o)[4], float& l_out, const int tid) {
  const int wid = tid >> 6, lane = tid & 63, r32 = lane & 31, hi = lane >> 5;
  bf16* V_lds = (bf16*)lds; bf16* K_lds = (bf16*)(lds + 2 * SHM_V);
  float* ws = (float*)(lds + 2 * SHM_V + 2 * SHM_K) + wid * 64; float* al_l = ws + 32;
  float m_reg = -1e30f, l_reg = 0; bf16x8 qr[8];
#pragma unroll
  for (int d = 0; d < 4; ++d) o[d] = f32x16{};
  const bf16* Qw = Qb + (long)(wid * QBLK + r32) * LDX + hi * 8;
#pragma unroll
  for (int d0 = 0; d0 < 8; ++d0) qr[d0] = ld8(Qw + d0 * 16);
  const int sr = tid >> 4, sc = (tid & 15) * 8, vst0 = v_st(sr, sc), vst1 = v_st(32 + sr, sc);
  const int vb0 = (int)(uintptr_t)V_lds + v_rd_base(lane);
  struct { bf16x8 vs0, vs1, ks0, ks1; } sr_[1];
  const unsigned vo0 = (unsigned)(sr * LDX + sc) * 2u;
  const __amdgpu_buffer_rsrc_t rsK = __builtin_amdgcn_make_buffer_rsrc((void*)Kh, (short)0, seq * (LDX * 2), 0x00020000), rsV = __builtin_amdgcn_make_buffer_rsrc((void*)Vh, (short)0, seq * (LDX * 2), 0x00020000);
#define BLD(rs, vo, so) __builtin_bit_cast(bf16x8, __builtin_amdgcn_raw_buffer_load_b128(rs, vo, so, 0))
#define SLOAD(i, k0) do { const unsigned so_ = (unsigned)(k0) * (unsigned)(LDX * 2); \
    sr_[i].vs0 = BLD(rsV, vo0, so_); sr_[i].vs1 = BLD(rsV, vo0, so_ + 32u * LDX * 2u); sr_[i].ks0 = BLD(rsK, vo0, so_); sr_[i].ks1 = BLD(rsK, vo0, so_ + 32u * LDX * 2u); } while (0)
#define SWRITE(b, i) do { *(bf16x8*)((char*)V_lds + (b) * SHM_V + vst0) = sr_[i].vs0;          \
    *(bf16x8*)((char*)V_lds + (b) * SHM_V + vst1) = sr_[i].vs1; int kc = sc * 2;               \
    *(bf16x8*)((char*)K_lds + (b) * SHM_K + KSWZ(sr, kc)) = sr_[i].ks0;                       \
    *(bf16x8*)((char*)K_lds + (b) * SHM_K + KSWZ(32 + sr, kc)) = sr_[i].ks1; } while (0)
#define SWAIT() asm volatile("s_waitcnt vmcnt(0)" ::: "memory")
#define RESC(a) do { if (__any((a) < 1.f)) { if (hi == 0) al_l[r32] = (a); asm volatile("s_waitcnt lgkmcnt(0)" ::: "memory"); \
    _Pragma("unroll") for (int d = 0; d < 4; ++d) _Pragma("unroll") for (int r = 0; r < 16; ++r) o[d][r] *= al_l[crow(r, hi)]; } } while (0)
  f32x16 pA0, pA1, pB0, pB1; float mnA, mnB, alA, alB; bf16x8 pa0, pa1, pa2, pa3; const int NT = seq / KVBLK;
  constexpr int SE = 0, SO = 0;
  SLOAD(SE, 0); asm volatile("s_waitcnt vmcnt(0)" ::: "memory");
  __syncthreads();
  SWRITE(0, SE); __syncthreads();
  qkt(pA0, pA1, K_lds, qr, r32, hi); partialSM(pA0, pA1, m_reg, mnA, alA);
  SLOAD(SO, KVBLK);
  SWAIT(); SWRITE(1, SO); __syncthreads();
  for (int j = 1; j + 1 < NT; j += 2) {
    SBAR(); qkt(pB0, pB1, (bf16*)((char*)K_lds + SHM_K), qr, r32, hi);
    finishSM(pA0, pA1, alA, l_reg, pa0, pa1, pa2, pa3); SBAR();
    SLOAD(SO, (j + 1) * KVBLK); SBAR();
    pv_d0(o, vb0, pa0, pa1, pa2, pa3); partialSM(pB0, pB1, m_reg, mnB, alB);
    __syncthreads(); SWAIT(); SWRITE(0, SE);
    RESC(alB); __syncthreads();
    SBAR(); qkt(pA0, pA1, K_lds, qr, r32, hi);
    finishSM(pB0, pB1, alB, l_reg, pa0, pa1, pa2, pa3); SBAR();
    SLOAD(SE, (j + 2) * KVBLK); SBAR();
    pv_d0(o, vb0 + (int)SHM_V, pa0, pa1, pa2, pa3); partialSM(pA0, pA1, m_reg, mnA, alA);
    __syncthreads(); SWAIT(); SWRITE(1, SO);
    RESC(alA); __syncthreads();
  }
  SBAR(); qkt(pB0, pB1, (bf16*)((char*)K_lds + SHM_K), qr, r32, hi);
  finishSM(pA0, pA1, alA, l_reg, pa0, pa1, pa2, pa3); SBAR();
  pv_d0(o, vb0, pa0, pa1, pa2, pa3); partialSM(pB0, pB1, m_reg, mnB, alB);
  __syncthreads(); RESC(alB);
  finishSM(pB0, pB1, alB, l_reg, pa0, pa1, pa2, pa3); SBAR();
  pv_d0(o, vb0 + (int)SHM_V, pa0, pa1, pa2, pa3);
  l_out = l_reg;
#undef SLOAD
#undef SWAIT
}

__device__ __forceinline__ void diff_unit(const bf16* __restrict__ QKV, float* __restrict__ DIFFO, int rb, int T, int h, int qb, int half, float lam, char* lds, const int tid0) {
#pragma unroll 1
  for (int n = 0; n < 2; ++n) {
    { unsigned z = 0; asm volatile("" : "+s"(z)); QKV += z; }
    const bf16* Qb = QKV + (size_t)(rb + qb * 256) * LDX + 3072 + (h * 2 + n) * 128;
    const bf16* Kh = QKV + (size_t)rb * LDX + 4096 + (h * 2 + n) * 128;
    const bf16* Vh = QKV + (size_t)rb * LDX + 5120 + h * 256 + half * 128;
    f32x16 o[4]; float l_reg;
    flash_pass(Qb, Kh, Vh, T, lds, o, l_reg, tid0);
    int tid = tid0; asm volatile("" : "+v"(tid));
    const int wid = __builtin_amdgcn_readfirstlane(tid >> 6), lane = tid & 63, r32 = lane & 31, hi = lane >> 5;
    float* li_l = (float*)(lds + 2 * SHM_V + 2 * SHM_K) + wid * 64;
    float* Ow = DIFFO + (size_t)(rb + qb * 256 + wid * QBLK) * 1024 + h * 256 + half * 128 + r32;
    if (hi == 0) li_l[r32] = l_reg; asm volatile("s_waitcnt lgkmcnt(0)" ::: "memory");
    const float sgn = n ? -lam : 1.0f;
#pragma unroll
    for (int r = 0; r < 16; ++r) { const int orow = crow(r, hi); const float rl = __builtin_amdgcn_rcpf(li_l[orow]) * sgn;
#pragma unroll
      for (int d0 = 0; d0 < 4; ++d0) { float* p = Ow + (size_t)orow * 1024 + d0 * 32; float v = o[d0][r] * rl; if (n) v += *p; *p = v; } }
  }
}

struct TrFrag { s16x4 l0, h0, l1, h1, l2, h2, l3, h3; };
template <int G> __device__ __forceinline__ void tr_frag(TrFrag& f, int vb) {
  constexpr int B = (G >> 2) * 16384, D0 = G & 3;
  f.l0 = tr_read<B + v_rd_off(D0, 0, 0)>(vb); f.h0 = tr_read<B + v_rd_off(D0, 0, 1)>(vb); f.l1 = tr_read<B + v_rd_off(D0, 1, 0)>(vb); f.h1 = tr_read<B + v_rd_off(D0, 1, 1)>(vb);
  f.l2 = tr_read<B + v_rd_off(D0, 2, 0)>(vb); f.h2 = tr_read<B + v_rd_off(D0, 2, 1)>(vb); f.l3 = tr_read<B + v_rd_off(D0, 3, 0)>(vb); f.h3 = tr_read<B + v_rd_off(D0, 3, 1)>(vb);
}
__device__ __forceinline__ void pv_mma(f32x16& od, const TrFrag& f, bf16x8 pa0, bf16x8 pa1, bf16x8 pa2, bf16x8 pa3) {
#define PK(L, H) (bf16x8){L[0], L[1], L[2], L[3], H[0], H[1], H[2], H[3]}
  od = __builtin_amdgcn_mfma_f32_32x32x16_bf16(pa0, PK(f.l0, f.h0), od, 0, 0, 0);
  od = __builtin_amdgcn_mfma_f32_32x32x16_bf16(pa1, PK(f.l1, f.h1), od, 0, 0, 0);
  od = __builtin_amdgcn_mfma_f32_32x32x16_bf16(pa2, PK(f.l2, f.h2), od, 0, 0, 0);
  od = __builtin_amdgcn_mfma_f32_32x32x16_bf16(pa3, PK(f.l3, f.h3), od, 0, 0, 0);
#undef PK
}
#define PV_STEP(G, CUR, NXT) do { tr_frag<(G) + 1>(NXT, vb); asm volatile("s_waitcnt lgkmcnt(8)" ::: "memory"); SBAR(); pv_mma(o[G], CUR, pa0, pa1, pa2, pa3); SBAR(); } while (0)
__device__ __forceinline__ void pv_pipe(f32x16* o, int vb, bf16x8 pa0, bf16x8 pa1, bf16x8 pa2, bf16x8 pa3) {
  TrFrag fa, fb;
  tr_frag<0>(fa, vb);
  PV_STEP(0, fa, fb); PV_STEP(1, fb, fa); PV_STEP(2, fa, fb); PV_STEP(3, fb, fa); PV_STEP(4, fa, fb); PV_STEP(5, fb, fa); PV_STEP(6, fa, fb);
  asm volatile("s_waitcnt lgkmcnt(0)" ::: "memory"); SBAR(); pv_mma(o[7], fb, pa0, pa1, pa2, pa3);
}
__device__ __forceinline__ void pv_pipe4(f32x16* o, int vb, bf16x8 pa0, bf16x8 pa1, bf16x8 pa2, bf16x8 pa3) {
  TrFrag fa, fb;
  tr_frag<0>(fa, vb);
  PV_STEP(0, fa, fb); PV_STEP(1, fb, fa); PV_STEP(2, fa, fb);
  asm volatile("s_waitcnt lgkmcnt(0)" ::: "memory"); SBAR(); pv_mma(o[3], fb, pa0, pa1, pa2, pa3);
}
#undef PV_STEP

struct TrFrag2 { s16x4 la, ha, lb, hb; };
template <int G, int KH> __device__ __forceinline__ void tr_frag2(TrFrag2& f, int vb) {
  constexpr int B = (G >> 2) * 16384, D0 = G & 3;
  f.la = tr_read<B + v_rd_off(D0, 2 * KH, 0)>(vb); f.ha = tr_read<B + v_rd_off(D0, 2 * KH, 1)>(vb); f.lb = tr_read<B + v_rd_off(D0, 2 * KH + 1, 0)>(vb); f.hb = tr_read<B + v_rd_off(D0, 2 * KH + 1, 1)>(vb);
}
__device__ __forceinline__ void pv_mma2(f32x16& od, const TrFrag2& f, bf16x8 pX, bf16x8 pY) {
#define PK(L, H) (bf16x8){L[0], L[1], L[2], L[3], H[0], H[1], H[2], H[3]}
  od = __builtin_amdgcn_mfma_f32_32x32x16_bf16(pX, PK(f.la, f.ha), od, 0, 0, 0);
  od = __builtin_amdgcn_mfma_f32_32x32x16_bf16(pY, PK(f.lb, f.hb), od, 0, 0, 0);
#undef PK
}
#define PKH(P, BASE, OUT) do { unsigned a0_ = cvtpk(P[BASE + 0], P[BASE + 1]), a1_ = cvtpk(P[BASE + 2], P[BASE + 3]); unsigned b0_ = cvtpk(P[BASE + 4], P[BASE + 5]), b1_ = cvtpk(P[BASE + 6], P[BASE + 7]); \
    auto r0_ = __builtin_amdgcn_permlane32_swap(a0_, b0_, false, false); auto r1_ = __builtin_amdgcn_permlane32_swap(a1_, b1_, false, false); \
    u32x4 w_ = {r0_[0], r1_[0], r0_[1], r1_[1]}; OUT = __builtin_bit_cast(bf16x8, w_); } while (0)
__device__ __forceinline__ void pv_half0_sm1(f32x16* o, int vb, bf16x8 pa0, bf16x8 pa1, f32x16& p1, float& ps1, bf16x8& pa2, bf16x8& pa3) {
  TrFrag2 fa, fb; float s1 = 0.f;
  tr_frag2<0, 0>(fa, vb);
#define H0_STEP(G, CUR, NXT, FILL) do { tr_frag2<(G) + 1, 0>(NXT, vb); asm volatile("s_waitcnt lgkmcnt(4)" ::: "memory"); SBAR(); pv_mma2(o[G], CUR, pa0, pa1); FILL; SBAR(); } while (0)
  H0_STEP(0, fa, fb, { p1[0] = __builtin_amdgcn_exp2f(p1[0]); p1[1] = __builtin_amdgcn_exp2f(p1[1]); p1[2] = __builtin_amdgcn_exp2f(p1[2]); p1[3] = __builtin_amdgcn_exp2f(p1[3]); });
  H0_STEP(1, fb, fa, { p1[4] = __builtin_amdgcn_exp2f(p1[4]); p1[5] = __builtin_amdgcn_exp2f(p1[5]); p1[6] = __builtin_amdgcn_exp2f(p1[6]); p1[7] = __builtin_amdgcn_exp2f(p1[7]); });
  H0_STEP(2, fa, fb, { p1[8] = __builtin_amdgcn_exp2f(p1[8]); p1[9] = __builtin_amdgcn_exp2f(p1[9]); p1[10] = __builtin_amdgcn_exp2f(p1[10]); p1[11] = __builtin_amdgcn_exp2f(p1[11]); });
  H0_STEP(3, fb, fa, { p1[12] = __builtin_amdgcn_exp2f(p1[12]); p1[13] = __builtin_amdgcn_exp2f(p1[13]); p1[14] = __builtin_amdgcn_exp2f(p1[14]); p1[15] = __builtin_amdgcn_exp2f(p1[15]); });
  H0_STEP(4, fa, fb, { s1 = ((p1[0] + p1[1]) + (p1[2] + p1[3])) + ((p1[4] + p1[5]) + (p1[6] + p1[7])); });
  H0_STEP(5, fb, fa, { s1 += ((p1[8] + p1[9]) + (p1[10] + p1[11])) + ((p1[12] + p1[13]) + (p1[14] + p1[15])); });
  H0_STEP(6, fa, fb, { PKH(p1, 0, pa2); });
  asm volatile("s_waitcnt lgkmcnt(0)" ::: "memory"); SBAR(); pv_mma2(o[7], fb, pa0, pa1); PKH(p1, 8, pa3); SBAR();
  ps1 = s1;
#undef H0_STEP
}
__device__ __forceinline__ void pv_half1(f32x16* o, int vb, bf16x8 pa2, bf16x8 pa3) {
  TrFrag2 fa, fb;
  tr_frag2<0, 1>(fa, vb);
#define H1_STEP(G, CUR, NXT) do { tr_frag2<(G) + 1, 1>(NXT, vb); asm volatile("s_waitcnt lgkmcnt(4)" ::: "memory"); SBAR(); pv_mma2(o[G], CUR, pa2, pa3); SBAR(); } while (0)
  H1_STEP(0, fa, fb); H1_STEP(1, fb, fa); H1_STEP(2, fa, fb); H1_STEP(3, fb, fa); H1_STEP(4, fa, fb); H1_STEP(5, fb, fa); H1_STEP(6, fa, fb);
  asm volatile("s_waitcnt lgkmcnt(0)" ::: "memory"); SBAR(); pv_mma2(o[7], fb, pa2, pa3);
#undef H1_STEP
}

#define SM_PIN(v) asm volatile("" : "+v"(v))
#define SM_FE(P, r) P[r] = __builtin_amdgcn_exp2f(fmaf(P[r], SCALE * 1.4426950408889634f, mnC))
__device__ __forceinline__ void pv_half0_sm1b(f32x16* o, int vb, bf16x8 pa0, bf16x8 pa1, const f32x16& p0, f32x16& p1, float mnC, float& ps, bf16x8& pa2, bf16x8& pa3) {
  TrFrag2 fa, fb; float s0 = 0.f;
  tr_frag2<0, 0>(fa, vb);
#define H0_STEP(G, CUR, NXT, FILL) do { tr_frag2<(G) + 1, 0>(NXT, vb); asm volatile("s_waitcnt lgkmcnt(4)" ::: "memory"); SBAR(); pv_mma2(o[G], CUR, pa0, pa1); FILL; SBAR(); } while (0)
  H0_STEP(0, fa, fb, { s0 = (((p0[0] + p0[1]) + (p0[2] + p0[3])) + ((p0[4] + p0[5]) + (p0[6] + p0[7]))) + (((p0[8] + p0[9]) + (p0[10] + p0[11])) + ((p0[12] + p0[13]) + (p0[14] + p0[15]))); SM_PIN(s0); });
  H0_STEP(1, fb, fa, { SM_FE(p1, 0); SM_FE(p1, 1); SM_FE(p1, 2); SM_FE(p1, 3); });
  H0_STEP(2, fa, fb, { SM_FE(p1, 4); SM_FE(p1, 5); SM_FE(p1, 6); SM_FE(p1, 7); });
  H0_STEP(3, fb, fa, { SM_FE(p1, 8); SM_FE(p1, 9); SM_FE(p1, 10); SM_FE(p1, 11); });
  H0_STEP(4, fa, fb, { SM_FE(p1, 12); SM_FE(p1, 13); SM_FE(p1, 14); SM_FE(p1, 15); });
  H0_STEP(5, fb, fa, { PKH(p1, 0, pa2); s0 += ((p1[0] + p1[1]) + (p1[2] + p1[3])) + ((p1[4] + p1[5]) + (p1[6] + p1[7])); SM_PIN(s0); });
  H0_STEP(6, fa, fb, { PKH(p1, 8, pa3); });
  asm volatile("s_waitcnt lgkmcnt(0)" ::: "memory"); SBAR(); pv_mma2(o[7], fb, pa0, pa1); s0 += ((p1[8] + p1[9]) + (p1[10] + p1[11])) + ((p1[12] + p1[13]) + (p1[14] + p1[15])); SM_PIN(s0); SBAR();
  ps = s0;
#undef H0_STEP
}
__device__ __forceinline__ void pv_half1_sum(f32x16* o, int vb, bf16x8 pa2, bf16x8 pa3, float ps, float alpha, float& l_reg) {
  TrFrag2 fa, fb;
  tr_frag2<0, 1>(fa, vb);
#define H1_STEP(G, CUR, NXT, FILL) do { tr_frag2<(G) + 1, 1>(NXT, vb); asm volatile("s_waitcnt lgkmcnt(4)" ::: "memory"); SBAR(); pv_mma2(o[G], CUR, pa2, pa3); FILL; SBAR(); } while (0)
  H1_STEP(0, fa, fb, { auto rr = __builtin_amdgcn_permlane32_swap(__float_as_uint(ps), __float_as_uint(ps), false, false); ps = __uint_as_float(rr[0]) + __uint_as_float(rr[1]); l_reg = l_reg * alpha + ps; SM_PIN(l_reg); });
  H1_STEP(1, fb, fa, {});
  H1_STEP(2, fa, fb, {}); H1_STEP(3, fb, fa, {}); H1_STEP(4, fa, fb, {}); H1_STEP(5, fb, fa, {}); H1_STEP(6, fa, fb, {});
  asm volatile("s_waitcnt lgkmcnt(0)" ::: "memory"); SBAR(); pv_mma2(o[7], fb, pa2, pa3);
#undef H1_STEP
}

constexpr int F2_K = 0, F2_V = 32768, F2_WS = 98304;
__device__ __forceinline__ void flash_pass2(const bf16* __restrict__ Qb, const bf16* __restrict__ Kh, const bf16* __restrict__ Vh, int seq, char* lds, LAS unsigned char* ldsl, f32x16 (&o)[8], float& l_out, const int tid) {
  const int wid = __builtin_amdgcn_readfirstlane(tid >> 6), lane = tid & 63, r32 = lane & 31, hi = lane >> 5;
  float* ws = (float*)(lds + F2_WS) + wid * 64; float* al_l = ws + 32;
  float m_reg = -1e30f, l_reg = 0; bf16x8 qr[8];
#pragma unroll
  for (int d = 0; d < 8; ++d) o[d] = f32x16{};
  const bf16* Qw = Qb + (long)(wid * QBLK + r32) * LDX + hi * 8;
#pragma unroll
  for (int d0 = 0; d0 < 8; ++d0) qr[d0] = ld8(Qw + d0 * 16);
  unsigned ko[2], va[2], vb_[2];
#pragma unroll
  for (int i = 0; i < 2; ++i) { const int j = 2 * wid + i;
    { const int row = 4 * j + (lane >> 4), pc = lane & 15, lc = pc ^ (row & 7); ko[i] = (unsigned)(row * LDX + lc * 8) * 2u; }
    { const int S = 64 * j + lane, sub = S >> 5, kk = (sub >> 2) * 8 + ((S & 31) >> 2), c = (sub & 3) * 32 + (S & 3) * 8;
      const int k = (kk & ~0xC) | ((kk & 4) << 1) | ((kk & 8) >> 1);
      va[i] = (unsigned)(k * LDX + c) * 2u; vb_[i] = va[i] + 256u; } }
#define F2_DMA(t, b) do { const char* kb_ = (const char*)Kh + (size_t)(t) * (64 * LDX * 2); const char* vb2_ = (const char*)Vh + (size_t)(t) * (64 * LDX * 2); \
    _Pragma("unroll") for (int i_ = 0; i_ < 2; ++i_) { \
      __builtin_amdgcn_global_load_lds((const unsigned*)(kb_ + ko[i_]), (LAS unsigned*)(ldsl + F2_K + (b) * 16384 + (2 * wid + i_) * 1024), 16, 0, 0); \
      __builtin_amdgcn_global_load_lds((const unsigned*)(vb2_ + va[i_]), (LAS unsigned*)(ldsl + F2_V + (b) * 32768 + (2 * wid + i_) * 1024), 16, 0, 0); \
      __builtin_amdgcn_global_load_lds((const unsigned*)(vb2_ + vb_[i_]), (LAS unsigned*)(ldsl + F2_V + (b) * 32768 + 16384 + (2 * wid + i_) * 1024), 16, 0, 0); } } while (0)
  const int vbase = (int)(uintptr_t)lds + F2_V + v_rd_base(lane), kbase = (int)(uintptr_t)lds + F2_K + r32 * 256;
  const int NT = seq / KVBLK;
  __syncthreads();
  F2_DMA(0, 0);
#pragma unroll 1
  for (int j = 0; j < NT; ++j) {
    const int b = j & 1;
    asm volatile("s_waitcnt vmcnt(0)" ::: "memory");
    __syncthreads();
    if (j + 1 < NT) F2_DMA(j + 1, b ^ 1);
    f32x16 p0, p1; float mn, alpha; bf16x8 pa0, pa1, pa2, pa3;
    qkt_pipe(p0, p1, kbase + b * 16384, (r32 & 7) << 4, hi * 16, qr);
    float mnC; partialSM2(p0, p1, m_reg, alpha, mnC);
    if (__any(alpha < 1.f)) { if (hi == 0) al_l[r32] = alpha; asm volatile("s_waitcnt lgkmcnt(0)" ::: "memory");
#pragma unroll
      for (int d = 0; d < 8; ++d)
#pragma unroll
        for (int r = 0; r < 16; ++r) o[d][r] *= al_l[crow(r, hi)]; }
#ifndef ATT_HALFSM
#define ATT_HALFSM 1
#endif
#if ATT_HALFSM
    {
      PKH(p0, 0, pa0); PKH(p0, 8, pa1); SBAR();
      float ps;
      pv_half0_sm1b(o, vbase + b * 32768, pa0, pa1, p0, p1, mnC, ps, pa2, pa3);
      pv_half1_sum(o, vbase + b * 32768, pa2, pa3, ps, alpha, l_reg);
    }
#else
    finishSM(p0, p1, alpha, l_reg, pa0, pa1, pa2, pa3); SBAR();
#ifndef ATT_PVPIPE
#define ATT_PVPIPE 1
#endif
#if ATT_PVPIPE
    pv_pipe(o, vbase + b * 32768, pa0, pa1, pa2, pa3);
#else
    pv_d0(o, vbase + b * 32768, pa0, pa1, pa2, pa3);
    pv_d0(o + 4, vbase + b * 32768 + 16384, pa0, pa1, pa2, pa3);
#endif
#endif
  }
  l_out = l_reg;
#undef F2_DMA
}
__device__ __forceinline__ void diff_unit2(const bf16* __restrict__ QKV, float* __restrict__ DIFFO, int rb, int T, int h, int qb, float lam, char* lds, LAS unsigned char* ldsl, const int tid0) {
#pragma unroll 1
  for (int n = 0; n < 2; ++n) {
    { unsigned z = 0; asm volatile("" : "+s"(z)); QKV += z; }
    const bf16* Qb = QKV + (size_t)(rb + qb * 256) * LDX + 3072 + (h * 2 + n) * 128;
    const bf16* Kh = QKV + (size_t)rb * LDX + 4096 + (h * 2 + n) * 128;
    const bf16* Vh = QKV + (size_t)rb * LDX + 5120 + h * 256;
    f32x16 o[8]; float l_reg;
    flash_pass2(Qb, Kh, Vh, T, lds, ldsl, o, l_reg, tid0);
    int tid = tid0; asm volatile("" : "+v"(tid));
    const int wid = __builtin_amdgcn_readfirstlane(tid >> 6), lane = tid & 63, r32 = lane & 31, hi = lane >> 5;
    float* li_l = (float*)(lds + F2_WS) + wid * 64;
    float* Ow = DIFFO + (size_t)(rb + qb * 256 + wid * QBLK) * 1024 + h * 256 + r32;
    if (hi == 0) li_l[r32] = l_reg; asm volatile("s_waitcnt lgkmcnt(0)" ::: "memory");
    const float sgn = n ? -lam : 1.0f;
#pragma unroll
    for (int r = 0; r < 16; ++r) { const int orow = crow(r, hi); const float rl = __builtin_amdgcn_rcpf(li_l[orow]) * sgn;
#pragma unroll
      for (int d0 = 0; d0 < 8; ++d0) { float* p = Ow + (size_t)orow * 1024 + d0 * 32; float v = o[d0][r] * rl; if (n) v += *p; *p = v; } }
  }
}

using f32x4 = __attribute__((ext_vector_type(4))) float;
__device__ __forceinline__ unsigned a16_off_a(unsigned row, unsigned ch) { return 2048u * (row >> 3) + 512u * (ch >> 2) + 64u * (row & 7) + 16u * ((ch & 3) ^ ((row >> 2) & 3)); }
__device__ __forceinline__ unsigned a16_xb(unsigned row) { return ((row & 3) << 2) | ((row >> 2) & 3); }
__device__ __forceinline__ unsigned a16_off_b(unsigned row, unsigned ch) { return 256u * row + 16u * (ch ^ a16_xb(row)); }
template <int OFF> __device__ __forceinline__ bf16x8 k16_read(int a) { bf16x8 r; asm volatile("ds_read_b128 %0, %1 offset:%2" : "=&v"(r) : "v"(a), "i"(OFF) : "memory"); return r; }
#define MF16(A, B, C) __builtin_amdgcn_mfma_f32_16x16x32_bf16(A, B, C, 0, 0, 0)
#define A16_XMAX(x) do { { auto r_ = __builtin_amdgcn_permlane16_swap(__float_as_uint(x), __float_as_uint(x), false, false); x = fmaxf(__uint_as_float(r_[0]), __uint_as_float(r_[1])); } \
                         { auto r_ = __builtin_amdgcn_permlane32_swap(__float_as_uint(x), __float_as_uint(x), false, false); x = fmaxf(__uint_as_float(r_[0]), __uint_as_float(r_[1])); } } while (0)
#define A16_XSUM(x) do { { auto r_ = __builtin_amdgcn_permlane16_swap(__float_as_uint(x), __float_as_uint(x), false, false); x = __uint_as_float(r_[0]) + __uint_as_float(r_[1]); } \
                         { auto r_ = __builtin_amdgcn_permlane32_swap(__float_as_uint(x), __float_as_uint(x), false, false); x = __uint_as_float(r_[0]) + __uint_as_float(r_[1]); } } while (0)
struct VF16 { s16x4 t0, t1; };
__device__ __forceinline__ void flash_pass16(const bf16* __restrict__ Qb, const bf16* __restrict__ Kh, const bf16* __restrict__ Vh, int seq, char* lds, LAS unsigned char* ldsl, f32x4 (&o)[2][16], float (&l_out)[2], const int tid) {
  constexpr float C = SCALE * 1.4426950408889634f;
  int tid_l = tid; asm volatile("" : "+v"(tid_l));
  const int wid = __builtin_amdgcn_readfirstlane(tid_l >> 6), lane = tid_l & 63, c16 = lane & 15, g = lane >> 4;
  float* ws = (float*)(lds + F2_WS) + wid * 64; float* al_l = ws + 32;
  float m_reg[2] = {-1e30f, -1e30f}, l_reg[2] = {0.f, 0.f}; bf16x8 qr[2][4];
#pragma unroll
  for (int qt = 0; qt < 2; ++qt)
#pragma unroll
    for (int dt = 0; dt < 16; ++dt) o[qt][dt] = f32x4{0.f, 0.f, 0.f, 0.f};
#pragma unroll
  for (int qt = 0; qt < 2; ++qt)
#pragma unroll
    for (int s4 = 0; s4 < 4; ++s4) qr[qt][s4] = ld8(Qb + (long)(wid * QBLK + 16 * qt + c16) * LDX + 32 * s4 + 8 * g);
  unsigned ko[2], va[2];
#pragma unroll
  for (int i = 0; i < 2; ++i) { const unsigned S = 64u * (2 * wid + i) + lane;
    { const unsigned row = S >> 4, ch = (S & 15) ^ a16_xb(row); ko[i] = (row * LDX + 8 * ch) * 2u; }
    { const unsigned row = 8 * (S >> 7) + ((S >> 2) & 7), ch = 4 * ((S >> 5) & 3) + ((S & 3) ^ ((row >> 2) & 3)); va[i] = (row * LDX + 8 * ch) * 2u; } }
#define F16_DMA(t, b) do { const char* kb_ = (const char*)Kh + (size_t)(t) * (64 * LDX * 2); const char* vb2_ = (const char*)Vh + (size_t)(t) * (64 * LDX * 2); \
    _Pragma("unroll") for (int i_ = 0; i_ < 2; ++i_) { \
      __builtin_amdgcn_global_load_lds((const unsigned*)(kb_ + ko[i_]), (LAS unsigned*)(ldsl + F2_K + (b) * 16384 + (2 * wid + i_) * 1024), 16, 0, 0); \
      __builtin_amdgcn_global_load_lds((const unsigned*)(vb2_ + va[i_]), (LAS unsigned*)(ldsl + F2_V + (b) * 32768 + (2 * wid + i_) * 1024), 16, 0, 0); \
      __builtin_amdgcn_global_load_lds((const unsigned*)(vb2_ + va[i_] + 256), (LAS unsigned*)(ldsl + F2_V + (b) * 32768 + 16384 + (2 * wid + i_) * 1024), 16, 0, 0); } } while (0)
  int kad[2][4], vad[2][2];
  { const unsigned krow0 = 8 * (c16 >> 2) + (c16 & 3);
#pragma unroll
    for (int t = 0; t < 2; ++t)
#pragma unroll
      for (int s4 = 0; s4 < 4; ++s4) kad[t][s4] = (int)(uintptr_t)lds + F2_K + (int)a16_off_b(krow0 + 4 * t, 4 * s4 + g);
    const unsigned qd = c16 >> 2, pp = c16 & 3;
#pragma unroll
    for (int c1 = 0; c1 < 2; ++c1)
#pragma unroll
      for (int t = 0; t < 2; ++t) vad[c1][t] = (int)(uintptr_t)lds + F2_V + (int)(a16_off_a(8 * g + 4 * t + qd, 2 * c1 + (pp >> 1)) + 8 * (pp & 1)); }
  const int NT = seq / KVBLK;
  __syncthreads();
  F16_DMA(0, 0);
#pragma unroll 1
  for (int j = 0; j < NT; ++j) {
    const int b = j & 1;
    asm volatile("s_waitcnt vmcnt(0)" ::: "memory");
    __syncthreads();
    if (j + 1 < NT) F16_DMA(j + 1, b ^ 1);
    f32x4 st[4][2];
#pragma unroll
    for (int kt = 0; kt < 4; ++kt) { st[kt][0] = f32x4{0.f, 0.f, 0.f, 0.f}; st[kt][1] = st[kt][0]; }
    { const int kb = b * 16384; bf16x8 kf[4];
#define K16_RD(n) ((((n) & 3) >> 1) ? k16_read<8192>(kad[(n) & 1][(n) >> 2] + kb) : k16_read<0>(kad[(n) & 1][(n) >> 2] + kb))
      kf[0] = K16_RD(0); kf[1] = K16_RD(1); kf[2] = K16_RD(2);
#pragma unroll
      for (int n = 0; n < 16; ++n) { const int kt = n & 3, s4 = n >> 2;
        if (n + 3 < 16) { kf[(n + 3) & 3] = K16_RD(n + 3); asm volatile("s_waitcnt lgkmcnt(3)" ::: "memory"); }
        else if (n + 2 < 16) asm volatile("s_waitcnt lgkmcnt(2)" ::: "memory");
        else if (n + 1 < 16) asm volatile("s_waitcnt lgkmcnt(1)" ::: "memory");
        else asm volatile("s_waitcnt lgkmcnt(0)" ::: "memory");
        SBAR();
        st[kt][0] = MF16(kf[n & 3], qr[0][s4], st[kt][0]); st[kt][1] = MF16(kf[n & 3], qr[1][s4], st[kt][1]);
        SBAR(); }
#undef K16_RD
    }
    float alpha[2], mnC[2]; bool ok = true;
#pragma unroll
    for (int qt = 0; qt < 2; ++qt) {
      float c0 = fmaxf(fmaxf(st[0][qt][0], st[0][qt][1]), fmaxf(st[0][qt][2], st[0][qt][3])), c1 = fmaxf(fmaxf(st[1][qt][0], st[1][qt][1]), fmaxf(st[1][qt][2], st[1][qt][3]));
      float c2 = fmaxf(fmaxf(st[2][qt][0], st[2][qt][1]), fmaxf(st[2][qt][2], st[2][qt][3])), c3 = fmaxf(fmaxf(st[3][qt][0], st[3][qt][1]), fmaxf(st[3][qt][2], st[3][qt][3]));
      float pm = fmaxf(fmaxf(c0, c1), fmaxf(c2, c3)); A16_XMAX(pm);
      mnC[qt] = pm;
      ok = ok && (pm - m_reg[qt] <= THR / SCALE); }
    if (__builtin_expect(__all(ok), 1)) { alpha[0] = 1.f; alpha[1] = 1.f; }
    else {
#pragma unroll
      for (int qt = 0; qt < 2; ++qt) { const float mn = fmaxf(m_reg[qt], mnC[qt]); alpha[qt] = __builtin_amdgcn_exp2f((m_reg[qt] - mn) * C); m_reg[qt] = mn; }
      if (g == 0) { al_l[c16] = alpha[0]; al_l[16 + c16] = alpha[1]; } asm volatile("s_waitcnt lgkmcnt(0)" ::: "memory");
#pragma unroll
      for (int qt = 0; qt < 2; ++qt) { const f32x4 a4 = *(const f32x4*)(al_l + 16 * qt + 4 * g);
#pragma unroll
        for (int dt = 0; dt < 16; ++dt) { o[qt][dt][0] *= a4[0]; o[qt][dt][1] *= a4[1]; o[qt][dt][2] *= a4[2]; o[qt][dt][3] *= a4[3]; } }
    }
    mnC[0] = -m_reg[0] * C; mnC[1] = -m_reg[1] * C;
    bf16x8 pa[2][2]; float ps0 = 0.f, ps1 = 0.f;
#define FE16(kt, qt, i) st[kt][qt][i] = __builtin_amdgcn_exp2f(fmaf(st[kt][qt][i], C, mnC[qt]))
#define PK16(qt, ks) do { u32x4 w_ = {cvtpk(st[2 * (ks)][qt][0], st[2 * (ks)][qt][1]), cvtpk(st[2 * (ks)][qt][2], st[2 * (ks)][qt][3]), cvtpk(st[2 * (ks) + 1][qt][0], st[2 * (ks) + 1][qt][1]), cvtpk(st[2 * (ks) + 1][qt][2], st[2 * (ks) + 1][qt][3])}; \
      pa[qt][ks] = __builtin_bit_cast(bf16x8, w_); } while (0)
#define SUM8(qt, ka, kb2) (((st[ka][qt][0] + st[ka][qt][1]) + (st[ka][qt][2] + st[ka][qt][3])) + ((st[kb2][qt][0] + st[kb2][qt][1]) + (st[kb2][qt][2] + st[kb2][qt][3])))
#pragma unroll
    for (int qt = 0; qt < 2; ++qt) {
#pragma unroll
      for (int kt = 0; kt < 2; ++kt)
#pragma unroll
        for (int i = 0; i < 4; ++i) FE16(kt, qt, i);
      PK16(qt, 0); }
    SBAR();
    { const int vbo = b * 32768; VF16 vf[3];
#define V16_RD(F, n) do { constexpr int c_ = (n) & 7, img_ = ((n) >> 3) & 1, ks_ = (n) >> 4, OFF_ = 8192 * ks_ + 512 * (c_ >> 1) + 16384 * img_; \
        F.t0 = tr_read<OFF_>(vad[c_ & 1][0] + vbo); F.t1 = tr_read<OFF_>(vad[c_ & 1][1] + vbo); } while (0)
#define V16_STEP(n, CI, W, PF, FILL) do { PF; asm volatile("s_waitcnt lgkmcnt(" #W ")" ::: "memory"); SBAR(); \
        { const VF16& cu_ = vf[CI]; const bf16x8 vb8_ = (bf16x8){cu_.t0[0], cu_.t0[1], cu_.t0[2], cu_.t0[3], cu_.t1[0], cu_.t1[1], cu_.t1[2], cu_.t1[3]}; \
          o[0][(n) & 15] = MF16(pa[0][(n) >> 4], vb8_, o[0][(n) & 15]); o[1][(n) & 15] = MF16(pa[1][(n) >> 4], vb8_, o[1][(n) & 15]); } FILL; SBAR(); } while (0)
      V16_RD(vf[0], 0); V16_RD(vf[1], 1);
      V16_STEP(0, 0, 4, V16_RD(vf[2], 2), { ps0 = SUM8(0, 0, 1); SM_PIN(ps0); });
      V16_STEP(1, 1, 4, V16_RD(vf[0], 3), { ps1 = SUM8(1, 0, 1); SM_PIN(ps1); });
      V16_STEP(2, 2, 4, V16_RD(vf[1], 4), { FE16(2, 0, 0); FE16(2, 0, 1); });
      V16_STEP(3, 0, 4, V16_RD(vf[2], 5), { FE16(2, 0, 2); FE16(2, 0, 3); });
      V16_STEP(4, 1, 4, V16_RD(vf[0], 6), { FE16(2, 1, 0); FE16(2, 1, 1); });
      V16_STEP(5, 2, 4, V16_RD(vf[1], 7), { FE16(2, 1, 2); FE16(2, 1, 3); });
      V16_STEP(6, 0, 4, V16_RD(vf[2], 8), { FE16(3, 0, 0); FE16(3, 0, 1); });
      V16_STEP(7, 1, 4, V16_RD(vf[0], 9), { FE16(3, 0, 2); FE16(3, 0, 3); });
      V16_STEP(8, 2, 4, V16_RD(vf[1], 10), { FE16(3, 1, 0); FE16(3, 1, 1); });
      V16_STEP(9, 0, 4, V16_RD(vf[2], 11), { FE16(3, 1, 2); FE16(3, 1, 3); });
      V16_STEP(10, 1, 4, V16_RD(vf[0], 12), { ps0 += SUM8(0, 2, 3); SM_PIN(ps0); });
      V16_STEP(11, 2, 4, V16_RD(vf[1], 13), { ps1 += SUM8(1, 2, 3); SM_PIN(ps1); });
      V16_STEP(12, 0, 4, V16_RD(vf[2], 14), { PK16(0, 1); });
      V16_STEP(13, 1, 4, V16_RD(vf[0], 15), { PK16(1, 1); });
      V16_STEP(14, 2, 4, V16_RD(vf[1], 16), { l_reg[0] = l_reg[0] * alpha[0] + ps0; l_reg[1] = l_reg[1] * alpha[1] + ps1; SM_PIN(l_reg[0]); SM_PIN(l_reg[1]); });
      V16_STEP(15, 0, 4, V16_RD(vf[2], 17), {});
      V16_STEP(16, 1, 4, V16_RD(vf[0], 18), {});
      V16_STEP(17, 2, 4, V16_RD(vf[1], 19), {});
      V16_STEP(18, 0, 4, V16_RD(vf[2], 20), {});
      V16_STEP(19, 1, 4, V16_RD(vf[0], 21), {});
      V16_STEP(20, 2, 4, V16_RD(vf[1], 22), {});
      V16_STEP(21, 0, 4, V16_RD(vf[2], 23), {});
      V16_STEP(22, 1, 4, V16_RD(vf[0], 24), {});
      V16_STEP(23, 2, 4, V16_RD(vf[1], 25), {});
      V16_STEP(24, 0, 4, V16_RD(vf[2], 26), {});
      V16_STEP(25, 1, 4, V16_RD(vf[0], 27), {});
      V16_STEP(26, 2, 4, V16_RD(vf[1], 28), {});
      V16_STEP(27, 0, 4, V16_RD(vf[2], 29), {});
      V16_STEP(28, 1, 4, V16_RD(vf[0], 30), {});
      V16_STEP(29, 2, 4, V16_RD(vf[1], 31), {});
      V16_STEP(30, 0, 2, (void)0, {});
      V16_STEP(31, 1, 0, (void)0, {});
#undef V16_STEP
#undef V16_RD
    }
#undef FE16
#undef PK16
#undef SUM8
  }
#pragma unroll
  for (int qt = 0; qt < 2; ++qt) { float l = l_reg[qt]; A16_XSUM(l); l_out[qt] = l; }
#undef F16_DMA
}
#ifndef ATT16_SUBLN
#define ATT16_SUBLN 1
#endif
#define A16_DPP(v, ctrl) __builtin_bit_cast(float, __builtin_amdgcn_update_dpp(0, __builtin_bit_cast(int, v), ctrl, 0xf, 0xf, true))
__device__ __forceinline__ const char* a16_kptr(int k) { const __attribute__((address_space(4))) char* ka = (const __attribute__((address_space(4))) char*)__builtin_amdgcn_kernarg_segment_ptr(); unsigned z = 0; asm volatile("" : "+s"(z));
  return (const char*)*(const __attribute__((address_space(1))) char* const __attribute__((address_space(4)))*)(ka + z + 8 * k); }
__device__ __forceinline__ void diff_unit16(const bf16* __restrict__ QKV, float* __restrict__ DIFFO, int jlayer, int rb, int T, int h, int qb, float lam, char* lds, LAS unsigned char* ldsl, const int tid0) {
#pragma unroll 1
  for (int n = 0; n < 2; ++n) {
    { unsigned z = 0; asm volatile("" : "+s"(z)); QKV += z; }
    const bf16* Qb = QKV + (size_t)(rb + qb * 256) * LDX + 3072 + (h * 2 + n) * 128;
    const bf16* Kh = QKV + (size_t)rb * LDX + 4096 + (h * 2 + n) * 128;
    const bf16* Vh = QKV + (size_t)rb * LDX + 5120 + h * 256;
    f32x4 o[2][16]; float l2[2];
    flash_pass16(Qb, Kh, Vh, T, lds, ldsl, o, l2, tid0);
    int tid = tid0; asm volatile("" : "+v"(tid));
    const int wid = __builtin_amdgcn_readfirstlane(tid >> 6), lane = tid & 63, c16 = lane & 15, g = lane >> 4;
    float* li_l = (float*)(lds + F2_WS) + wid * 64;
    if (g == 0) { li_l[c16] = l2[0]; li_l[16 + c16] = l2[1]; } asm volatile("s_waitcnt lgkmcnt(0)" ::: "memory");
    const float sgn = n ? -lam : 1.0f;
#if ATT16_SUBLN
    if (n == 0) {
#endif
#pragma unroll
    for (int qt = 0; qt < 2; ++qt) { const f32x4 l4 = *(const f32x4*)(li_l + 16 * qt + 4 * g);
#pragma unroll
      for (int i = 0; i < 4; ++i) { const float rl = __builtin_amdgcn_rcpf(l4[i]) * sgn;
        float* Ow = DIFFO + (size_t)(rb + qb * 256 + wid * QBLK + 16 * qt + 4 * g + i) * 1024 + h * 256 + c16;
#pragma unroll
        for (int dt = 0; dt < 16; ++dt) { float* p = Ow + 16 * dt; float v = o[qt][dt][i] * rl; if (n) v += *p; *p = v; } } }
#if ATT16_SUBLN
    } else {
      const float* subw = (const float*)a16_kptr(16) + jlayer * 256; bf16* ATTO = (bf16*)a16_kptr(26) + (size_t)49152 * 2048;
      const float one_minus_li = jlayer ? 0.5292869816564158f : 0.8f;
      float gw[16];
#pragma unroll
      for (int dt = 0; dt < 16; ++dt) gw[dt] = subw[16 * dt + c16] * one_minus_li;
      const bool odd = c16 & 1;
#pragma unroll
      for (int qt = 0; qt < 2; ++qt) { const f32x4 l4 = *(const f32x4*)(li_l + 16 * qt + 4 * g);
#pragma unroll
        for (int i = 0; i < 4; ++i) { const float rl = __builtin_amdgcn_rcpf(l4[i]) * sgn;
          const size_t row = (size_t)(rb + qb * 256 + wid * QBLK + 16 * qt + 4 * g + i);
          const float* Ow = DIFFO + row * 1024 + h * 256 + c16;
          float o1[16];
#pragma unroll
          for (int dt = 0; dt < 16; ++dt) o1[dt] = Ow[16 * dt];
          float ss = 0.f;
#pragma unroll
          for (int dt = 0; dt < 16; ++dt) { const float v = fmaf(o[qt][dt][i], rl, o1[dt]); o1[dt] = v; ss = fmaf(v, v, ss); }
          ss += A16_DPP(ss, 0xB1); ss += A16_DPP(ss, 0x4E); ss += A16_DPP(ss, 0x141); ss += A16_DPP(ss, 0x140);
          const float r = __builtin_amdgcn_rsqf(ss * (1.0f / 256.0f) + 1e-6f);
          bf16* Ar = ATTO + row * 2048 + 1024 + h * 256 + (odd ? 16 + c16 - 1 : c16);
#pragma unroll
          for (int k = 0; k < 8; ++k) { const float a = o1[2 * k] * r * gw[2 * k], b2 = o1[2 * k + 1] * r * gw[2 * k + 1];
            const float snd = odd ? a : b2, rcv = A16_DPP(snd, 0xB1);
            *(unsigned*)(Ar + 32 * k) = odd ? cvtpk(rcv, b2) : cvtpk(a, rcv); } } }
    }
#endif
  }
}
#undef MF16

#ifndef NA_DMA
#define NA_DMA 1
#endif
#if NA_DMA
__device__ __forceinline__ void na_unit(const bf16* __restrict__ QKV, bf16* __restrict__ ATT, const float* __restrict__ rpb_h, int rb, int rows, int h, int band, char* lds, const int tid) {
  const int wid = __builtin_amdgcn_readfirstlane(tid >> 6), lane = tid & 63, r32 = lane & 31, hi = lane >> 5;
  LAS unsigned char* ldsl = (LAS unsigned char*)(unsigned)(uintptr_t)lds;
  float* ws = (float*)(lds + F2_WS) + wid * 64; float* li_l = ws; float* al_l = ws + 32;
  float* rpb_l = (float*)(lds + F2_WS + 2048);
  const int r0 = band * 4, r = r0 + (wid >> 1), cb = (wid & 1) * 32, c = cb + r32;
  const int rs = min(max(r - 4, 0), rows - 8), cs = min(max(c - 8, 0), 48);
  const int kr_lo = min(max(r0 - 4, 0), rows - 8), kr_hi = min(max(r0 - 1, 0), rows - 8) + 7;
  __syncthreads();
  for (int i = tid; i < 15 * 31; i += 512) rpb_l[i] = rpb_h[i];
  float m_reg = -1e30f, l_reg = 0; f32x16 o[4]; bf16x8 qr[8];
#pragma unroll
  for (int d = 0; d < 4; ++d) o[d] = f32x16{};
  const bf16* Qw = QKV + (size_t)(rb + r * 64 + c) * LDX + h * 128 + hi * 8;
#pragma unroll
  for (int d0 = 0; d0 < 8; ++d0) qr[d0] = ld8(Qw + d0 * 16);
  const bf16* Kh = QKV + (size_t)rb * LDX + 1024 + h * 128;
  const bf16* Vh = QKV + (size_t)rb * LDX + 2048 + h * 128;
  unsigned ko[2], va[2];
#pragma unroll
  for (int i = 0; i < 2; ++i) { const int j = 2 * wid + i;
    { const int row = 4 * j + (lane >> 4), pc = lane & 15, lc = pc ^ (row & 7); ko[i] = (unsigned)(row * LDX + lc * 8) * 2u; }
    { const int S = 64 * j + lane, sub = S >> 5, kk = (sub >> 2) * 8 + ((S & 31) >> 2), cc = (sub & 3) * 32 + (S & 3) * 8;
      const int k = (kk & ~0xC) | ((kk & 4) << 1) | ((kk & 8) >> 1);
      va[i] = (unsigned)(k * LDX + cc) * 2u; } }
#define NA_DMA_TILE(t, b) do { const char* kb_ = (const char*)Kh + (size_t)(t) * (64 * LDX * 2); const char* vb2_ = (const char*)Vh + (size_t)(t) * (64 * LDX * 2); \
    _Pragma("unroll") for (int i_ = 0; i_ < 2; ++i_) { \
      __builtin_amdgcn_global_load_lds((const unsigned*)(kb_ + ko[i_]), (LAS unsigned*)(ldsl + F2_K + (b) * 16384 + (2 * wid + i_) * 1024), 16, 0, 0); \
      __builtin_amdgcn_global_load_lds((const unsigned*)(vb2_ + va[i_]), (LAS unsigned*)(ldsl + F2_V + (b) * 32768 + (2 * wid + i_) * 1024), 16, 0, 0); } } while (0)
  const int vbase = (int)(uintptr_t)lds + F2_V + v_rd_base(lane), kbase = (int)(uintptr_t)lds + F2_K + r32 * 256;
  NA_DMA_TILE(kr_lo, 0);
#pragma unroll 1
  for (int kr = kr_lo; kr <= kr_hi; ++kr) {
    const int b = (kr - kr_lo) & 1;
    asm volatile("s_waitcnt vmcnt(0)" ::: "memory");
    __syncthreads();
    if (kr < kr_hi) NA_DMA_TILE(kr + 1, b ^ 1);
    if (kr >= rs && kr <= rs + 7) {
      f32x16 p0, p1; float mn, alpha; bf16x8 pa0, pa1, pa2, pa3;
      qkt_pipe(p0, p1, kbase + b * 16384, (r32 & 7) << 4, hi * 16, qr);
      const float* brow = rpb_l + (kr - r + 7) * 31 + (15 - c);
      constexpr float ISC = 1.0f / SCALE;
#pragma unroll
      for (int q = 0; q < 16; ++q) { const int kc = crow(q, hi);
        { const bool ok = (kc >= cs) && (kc < cs + 16); const float bb = brow[ok ? kc : cs]; p0[q] = ok ? fmaf(bb, ISC, p0[q]) : -INFINITY; }
        { const int k2 = kc + 32; const bool ok = (k2 >= cs) && (k2 < cs + 16); const float bb = brow[ok ? k2 : cs]; p1[q] = ok ? fmaf(bb, ISC, p1[q]) : -INFINITY; } }
      partialSM(p0, p1, m_reg, mn, alpha);
      RESC(alpha);
      finishSM(p0, p1, alpha, l_reg, pa0, pa1, pa2, pa3); SBAR();
      pv_pipe4(o, vbase + b * 32768, pa0, pa1, pa2, pa3);
    }
  }
#undef NA_DMA_TILE
  if (hi == 0) li_l[r32] = l_reg; asm volatile("s_waitcnt lgkmcnt(0)" ::: "memory");
  bf16* Ow = ATT + (size_t)(rb + r * 64 + cb) * 2048 + h * 128;
#pragma unroll
  for (int q = 0; q < 16; ++q) { const int orow = crow(q, hi); const float rl = __builtin_amdgcn_rcpf(li_l[orow]);
#pragma unroll
    for (int d0 = 0; d0 < 4; ++d0) { const unsigned w = cvtpk(o[d0][q] * rl, 0.f); Ow[(size_t)orow * 2048 + d0 * 32 + r32] = (bf16)(w & 0xffffu); } }
}
#else
__device__ __forceinline__ void na_unit(const bf16* __restrict__ QKV, bf16* __restrict__ ATT, const float* __restrict__ rpb_h, int rb, int rows, int h, int band, char* lds, const int tid) {
  const int wid = tid >> 6, lane = tid & 63, r32 = lane & 31, hi = lane >> 5;
  bf16* V_lds = (bf16*)lds; bf16* K_lds = (bf16*)(lds + 2 * SHM_V);
  float* ws = (float*)(lds + 2 * SHM_V + 2 * SHM_K) + wid * 64; float* li_l = ws; float* al_l = ws + 32;
  float* rpb_l = (float*)(lds + SHM_RPB);
  const int r0 = band * 4, r = r0 + (wid >> 1), cb = (wid & 1) * 32, c = cb + r32;
  const int rs = min(max(r - 4, 0), rows - 8), cs = min(max(c - 8, 0), 48);
  const int kr_lo = min(max(r0 - 4, 0), rows - 8), kr_hi = min(max(r0 - 1, 0), rows - 8) + 7;
  __syncthreads();
  for (int i = tid; i < 15 * 31; i += 512) rpb_l[i] = rpb_h[i];
  float m_reg = -1e30f, l_reg = 0; f32x16 o[4]; bf16x8 qr[8];
#pragma unroll
  for (int d = 0; d < 4; ++d) o[d] = f32x16{};
  const bf16* Qw = QKV + (size_t)(rb + r * 64 + c) * LDX + h * 128 + hi * 8;
#pragma unroll
  for (int d0 = 0; d0 < 8; ++d0) qr[d0] = ld8(Qw + d0 * 16);
  const bf16* Kh = QKV + (size_t)rb * LDX + 1024 + h * 128;
  const bf16* Vh = QKV + (size_t)rb * LDX + 2048 + h * 128;
  const int sr = tid >> 4, sc = (tid & 15) * 8, vst0 = v_st(sr, sc), vst1 = v_st(32 + sr, sc);
  const int vb0 = (int)(uintptr_t)V_lds + v_rd_base(lane);
  const unsigned vo0 = (unsigned)(sr * LDX + sc) * 2u;
  const __amdgpu_buffer_rsrc_t rsK = __builtin_amdgcn_make_buffer_rsrc((void*)Kh, (short)0, rows * 64 * (LDX * 2), 0x00020000), rsV = __builtin_amdgcn_make_buffer_rsrc((void*)Vh, (short)0, rows * 64 * (LDX * 2), 0x00020000);
  bf16x8 vs0, vs1, ks0, ks1;
  { const unsigned so_ = (unsigned)(kr_lo * 64) * (unsigned)(LDX * 2);
    vs0 = BLD(rsV, vo0, so_); vs1 = BLD(rsV, vo0, so_ + 32u * LDX * 2u); ks0 = BLD(rsK, vo0, so_); ks1 = BLD(rsK, vo0, so_ + 32u * LDX * 2u); }
#pragma unroll 1
  for (int kr = kr_lo; kr <= kr_hi; ++kr) {
    __syncthreads();
    *(bf16x8*)((char*)V_lds + vst0) = vs0; *(bf16x8*)((char*)V_lds + vst1) = vs1;
    *(bf16x8*)((char*)K_lds + KSWZ(sr, sc * 2)) = ks0; *(bf16x8*)((char*)K_lds + KSWZ(32 + sr, sc * 2)) = ks1;
    __syncthreads();
    if (kr < kr_hi) { const unsigned so_ = (unsigned)((kr + 1) * 64) * (unsigned)(LDX * 2);
      vs0 = BLD(rsV, vo0, so_); vs1 = BLD(rsV, vo0, so_ + 32u * LDX * 2u); ks0 = BLD(rsK, vo0, so_); ks1 = BLD(rsK, vo0, so_ + 32u * LDX * 2u); }
    if (kr >= rs && kr <= rs + 7) {
      f32x16 p0, p1; float mn, alpha; bf16x8 pa0, pa1, pa2, pa3;
      qkt(p0, p1, K_lds, qr, r32, hi);
      const float* brow = rpb_l + (kr - r + 7) * 31 + (15 - c);
      constexpr float ISC = 1.0f / SCALE;
#pragma unroll
      for (int q = 0; q < 16; ++q) { const int kc = crow(q, hi);
        { const bool ok = (kc >= cs) && (kc < cs + 16); const float b = brow[ok ? kc : cs]; p0[q] = ok ? fmaf(b, ISC, p0[q]) : -INFINITY; }
        { const int k2 = kc + 32; const bool ok = (k2 >= cs) && (k2 < cs + 16); const float b = brow[ok ? k2 : cs]; p1[q] = ok ? fmaf(b, ISC, p1[q]) : -INFINITY; } }
      partialSM(p0, p1, m_reg, mn, alpha);
      RESC(alpha);
      finishSM(p0, p1, alpha, l_reg, pa0, pa1, pa2, pa3); SBAR();
      pv_d0(o, vb0, pa0, pa1, pa2, pa3);
    }
  }
  if (hi == 0) li_l[r32] = l_reg; asm volatile("s_waitcnt lgkmcnt(0)" ::: "memory");
  bf16* Ow = ATT + (size_t)(rb + r * 64 + cb) * 2048 + h * 128;
#pragma unroll
  for (int q = 0; q < 16; ++q) { const int orow = crow(q, hi); const float rl = __builtin_amdgcn_rcpf(li_l[orow]);
#pragma unroll
    for (int d0 = 0; d0 < 4; ++d0) { const unsigned w = cvtpk(o[d0][q] * rl, 0.f); Ow[(size_t)orow * 2048 + d0 * 32 + r32] = (bf16)(w & 0xffffu); } }
}
#endif
#undef SWRITE
#undef RESC
#undef BLD
#undef KSWZ
#undef SBAR
}

#define XB_TMO      128
#define XB_XCNT(j)  (256  + 64 * (j))
#define XB_XSUB(j)  (1280 + 64 * (j))
#define XB_XGEN(j)  (2304 + 64 * (j))
#define XB_TOP      3328
#define XB_TOPGEN   3392
#define XCD_BAR_WORDS 3456
#define XB_SPIN_CAP (1u << 18)

__device__ __forceinline__ unsigned xb_ld(unsigned* p)              { return __hip_atomic_load(p, __ATOMIC_RELAXED, __HIP_MEMORY_SCOPE_AGENT); }
__device__ __forceinline__ unsigned xb_add(unsigned* p, unsigned v) { return __hip_atomic_fetch_add(p, v, __ATOMIC_RELAXED, __HIP_MEMORY_SCOPE_AGENT); }
__device__ __forceinline__ unsigned xb_xcc_id() { return (unsigned)__builtin_amdgcn_s_getreg((3 << 11) | 20) & 0xFu; }
#define XB_SPIN(cond, bar) do { unsigned _sp = 0; while (cond) { __builtin_amdgcn_s_sleep(1); \
    if ((++_sp & 255u) == 0u) { if (xb_ld(&(bar)[XB_TMO])) break; if (_sp > XB_SPIN_CAP) { atomicAdd(&(bar)[XB_TMO], 1u); break; } } } } while (0)

__device__ __forceinline__ unsigned xb_lane() { unsigned l; asm volatile("v_mbcnt_lo_u32_b32 %0, -1, 0\n\tv_mbcnt_hi_u32_b32 %0, -1, %0" : "=v"(l)); return l; }
struct XcdBarrier {
    unsigned wave;
    unsigned* bar; unsigned x;
    volatile LAS unsigned* st;
};

__device__ __forceinline__ XcdBarrier xcd_barrier_post(unsigned* bar, volatile LAS unsigned* st, unsigned wave) {
    XcdBarrier b; b.wave = wave; b.bar = bar; b.x = xb_xcc_id(); b.st = st;
    if (wave == 0u && xb_lane() == 0u) (void)xb_add(&bar[XB_XCNT(b.x)], 1u);
    return b;
}
__device__ __forceinline__ void xcd_barrier_complete(unsigned* bar, unsigned x, unsigned& nloc, unsigned& nx) {
    const unsigned G = gridDim.x * gridDim.y * gridDim.z;
    unsigned sum, cnt, mine, sp = 0u;
    for (;;) {
        sum = 0u; cnt = 0u; mine = 0u;
#pragma unroll
        for (unsigned j = 0; j < 16; ++j) { const unsigned c = xb_ld(&bar[XB_XCNT(j)]); sum += c; cnt += (c > 0u) ? 1u : 0u; mine = (j == x) ? c : mine; }
        if (sum == G) break;
        __builtin_amdgcn_s_sleep(1);
        if ((++sp & 255u) == 0u) { if (xb_ld(&bar[XB_TMO])) break; if (sp > XB_SPIN_CAP) { atomicAdd(&bar[XB_TMO], 1u); break; } }
    }
    nloc = mine > 0u ? mine : 1u; nx = cnt > 0u ? cnt : 1u;
}

__device__ __forceinline__ void xcd_barrier(const XcdBarrier& b) {
    asm volatile("s_waitcnt vmcnt(0)" ::: "memory");
    __syncthreads();
    if (b.wave == 0u && xb_lane() == 0u) {
        unsigned* bar = b.bar; unsigned bx_ = b.x; { unsigned z_ = 0; asm volatile("" : "+s"(z_)); bar += z_; bx_ += z_; }
        __builtin_amdgcn_s_waitcnt(0);
        unsigned nloc = b.st[0], nx = b.st[1];
        if (nloc == 0u) { xcd_barrier_complete(bar, bx_, nloc, nx); b.st[0] = nloc; b.st[1] = nx; }
        const unsigned old = xb_add(&bar[XB_XSUB(bx_)], 1u);
        const unsigned gen = old / nloc;
        if (old + 1u == (gen + 1u) * nloc) {
            __builtin_amdgcn_fence(__ATOMIC_RELEASE, "agent");
            asm volatile("s_waitcnt vmcnt(0)" ::: "memory");
            const unsigned og = xb_add(&bar[XB_TOP], 1u);
            const unsigned tg = og / nx;
            if (og + 1u == (tg + 1u) * nx) xb_add(&bar[XB_TOPGEN], 1u);
            else XB_SPIN(xb_ld(&bar[XB_TOPGEN]) == tg, bar);
            __builtin_amdgcn_fence(__ATOMIC_ACQUIRE, "agent");
            xb_add(&bar[XB_XGEN(bx_)], 1u);
            asm volatile("s_waitcnt vmcnt(0)" ::: "memory");
        } else {
            XB_SPIN(xb_ld(&bar[XB_XGEN(bx_)]) == gen, bar);
            __builtin_amdgcn_fence(__ATOMIC_ACQUIRE, "agent");
            asm volatile("s_waitcnt vmcnt(0)" ::: "memory");
        }
    }
    __syncthreads();
}

constexpr int DM = 2048, FF = 5632, MROWS = 49152, NLAYER = 4;
constexpr int T_PROMPT = 16384, T_SAMPLE = 2048, ROWS_PROMPT = 32768;
constexpr int NSEQ = 10;
constexpr float NORM_EPS = 1e-6f;
constexpr int NWAVES = 8;
constexpr size_t MiB = 1u << 20;
constexpr size_t WS_CTL = 0, CTL_ZERO_BYTES = 1 * MiB;
constexpr size_t WS_ADA = 2 * MiB;
constexpr size_t WS_ROT = 4 * MiB;
constexpr size_t WS_W_AIN = 8 * MiB;
constexpr size_t WS_W_AOUT = WS_W_AIN + 48 * MiB;
constexpr size_t WS_W_GLU = WS_W_AOUT + 16 * MiB;
constexpr size_t WS_W_FIN = WS_W_GLU + 32 * MiB;
constexpr size_t WS_W_FOUT = WS_W_FIN + 176 * MiB;
constexpr size_t WS_H = WS_W_FOUT + 88 * MiB;
constexpr size_t WS_ATT = WS_H + 192 * MiB;
constexpr size_t WS_MIX = WS_ATT + 192 * MiB;
constexpr size_t WS_BIG = WS_MIX + 192 * MiB;
constexpr size_t WS_S5LAM = WS_BIG + 576 * MiB;
constexpr size_t WS_S5L64 = WS_S5LAM + 1 * MiB;
constexpr size_t WS_S5BOP = WS_S5LAM + 2 * MiB;
constexpr size_t WS_S5COP = WS_S5LAM + 4 * MiB;
constexpr size_t WS_END = WS_S5LAM + 6 * MiB;
static_assert(WS_H == 368 * MiB && WS_END == 1526 * MiB, "ws map");
constexpr int S5_L = 64, S5_NCH = MROWS / S5_L;
constexpr size_t S5_STATE_BYTES = (size_t)2 * 128 * S5_NCH * 64 * 8;
constexpr size_t WS_S5E = WS_BIG, WS_S5X = WS_BIG + 128 * MiB;
static_assert(S5_STATE_BYTES <= 128 * MiB, "s5 state");
constexpr int CW_BAR = 4096;
constexpr int CW_NORM = 65536, NORM_BANK = 24 * 64;
static_assert((CW_NORM + 8 * NORM_BANK) * 4 <= (int)CTL_ZERO_BYTES, "counters inside the per-call memset");
constexpr int RING_BYTES = 131072;
constexpr int LDSCTL_OFF = RING_BYTES, MISC_OFF = LDSCTL_OFF + 320;
constexpr int LDS_BYTES = 147456;

#ifndef MERGED_V
#define MERGED_V 1
#endif
#define GAS __attribute__((address_space(1)))
typedef unsigned short bf16;
typedef unsigned v4u __attribute__((ext_vector_type(4)));
typedef unsigned v2u __attribute__((ext_vector_type(2)));
typedef float f32x4 __attribute__((ext_vector_type(4)));
typedef float f32x16 __attribute__((ext_vector_type(16)));
typedef short bf16x8 __attribute__((ext_vector_type(8)));
#define LDS_WAIT() asm volatile("s_waitcnt lgkmcnt(0)" ::: "memory")
#define VM_WAIT() asm volatile("s_waitcnt vmcnt(0)" ::: "memory")
__device__ __forceinline__ unsigned pk2(float lo, float hi) { typedef __bf16 bfx2_ __attribute__((ext_vector_type(2))); typedef float flx2_ __attribute__((ext_vector_type(2))); const flx2_ v_ = {lo, hi}; return __builtin_bit_cast(unsigned, __builtin_convertvector(v_, bfx2_)); }
__device__ __forceinline__ float bf_lo(unsigned w) { return __uint_as_float(w << 16); }
__device__ __forceinline__ float bf_hi(unsigned w) { return __uint_as_float(w & 0xffff0000u); }
#define WS_DPP(v, ctrl) __builtin_bit_cast(float, __builtin_amdgcn_update_dpp(0, __builtin_bit_cast(int, v), ctrl, 0xf, 0xf, true))
__device__ __forceinline__ float wave_sum(float v) {
    v += WS_DPP(v, 0xB1); v += WS_DPP(v, 0x4E); v += WS_DPP(v, 0x141); v += WS_DPP(v, 0x140);
    v += __builtin_bit_cast(float, __builtin_amdgcn_ds_swizzle(__builtin_bit_cast(int, v), 0x401F));
    { auto rr = __builtin_amdgcn_permlane32_swap(__float_as_uint(v), __float_as_uint(v), false, false); v = __uint_as_float(rr[0]) + __uint_as_float(rr[1]); }
    return v;
}
__device__ __forceinline__ int seq_of_row(int m) { return m < ROWS_PROMPT ? (m >> 14) : 2 + ((m - ROWS_PROMPT) >> 11); }
__device__ __forceinline__ int pos_of_row(int m) { return m < ROWS_PROMPT ? (m & (T_PROMPT - 1)) : ((m - ROWS_PROMPT) & (T_SAMPLE - 1)); }

#define XBUF(F) ((bf16*)((F).ws + WS_H))
#define HBUF(F) ((bf16*)(F).out)
#define ATTBUF(F) ((bf16*)(F).out + (size_t)MROWS * DM)
struct Args { const float* in[26]; float* out; unsigned char* ws; int ph_lo, ph_hi; };
static_assert(sizeof(Args) == 28 * 8 + 8, "Args has no padding");
__device__ __forceinline__ const float* inptr(int k) { const __attribute__((address_space(4))) char* ka = (const __attribute__((address_space(4))) char*)__builtin_amdgcn_kernarg_segment_ptr(); unsigned z = 0; asm volatile("" : "+s"(z));
    return (const float*)*(const GAS float* const __attribute__((address_space(4)))*)(ka + z + 8 * k); }
struct Frame {
    LAS unsigned char* lds; char* ldsg;
    int tid, lane, wave, vcu, G, gw, NGW;
    float* out; unsigned char* ws;
};

__device__ __forceinline__ void transpose_item(const float* W, int K, int N, bf16* WT, int gate_half, LAS float* scr, int item, int lane) {
    const int nblk = N / 32, kb = item / nblk, nb = item % nblk, k0 = 64 * kb, n0 = 32 * nb;
#pragma unroll 8
    for (int i = 0; i < 32; ++i) { const int kk = 2 * i + (lane >> 5); scr[kk * 33 + (lane & 31)] = W[(size_t)(k0 + kk) * N + n0 + (lane & 31)]; }
    LDS_WAIT(); asm volatile("" ::: "memory");
    int d0 = n0;
    if (gate_half > 0) { d0 = (n0 < gate_half) ? ((n0 >> 7) * 256 + (n0 & 127)) : ((((n0 - gate_half) >> 7) * 256) + 128 + ((n0 - gate_half) & 127)); }
    const int c = lane & 7;
#pragma unroll
    for (int j = 0; j < 4; ++j) { const int n = (lane >> 3) + 8 * j; const LAS float* s = scr + (8 * c) * 33 + n;
        v4u o; o.x = pk2(s[0 * 33], s[1 * 33]); o.y = pk2(s[2 * 33], s[3 * 33]); o.z = pk2(s[4 * 33], s[5 * 33]); o.w = pk2(s[6 * 33], s[7 * 33]);
        *(GAS v4u*)(WT + (size_t)(d0 + n) * K + k0 + 8 * c) = o; }
    LDS_WAIT(); asm volatile("" ::: "memory");
}

__device__ __forceinline__ void p0_prologue(Frame& F, const Args& KA) {
    LAS float* scr = (LAS float*)(F.lds + F.wave * 16384);
    constexpr int I_AIN = (DM / 64) * (6144 / 32), I_AOUT = (DM / 64) * (DM / 32), I_GLU = (DM / 64) * (4096 / 32), I_FIN = (DM / 64) * (2 * FF / 32), I_FOUT = (FF / 64) * (DM / 32);
    constexpr int NITEMS = 2 * I_AIN + 2 * I_AOUT + 2 * I_GLU + 4 * I_FIN + 4 * I_FOUT;
    for (int it = F.gw; it < NITEMS; it += F.NGW) {
        int r = it;
        if (r < 2 * I_AIN) { const int j = r / I_AIN; transpose_item(inptr(12) + (size_t)j * DM * 6144, DM, 6144, (bf16*)(F.ws + WS_W_AIN) + (size_t)j * 6144 * DM, 0, scr, r % I_AIN, F.lane); continue; } r -= 2 * I_AIN;
        if (r < 2 * I_AOUT) { const int j = r / I_AOUT; transpose_item(inptr(13) + (size_t)j * DM * DM, DM, DM, (bf16*)(F.ws + WS_W_AOUT) + (size_t)j * DM * DM, 0, scr, r % I_AOUT, F.lane); continue; } r -= 2 * I_AOUT;
        if (r < 2 * I_GLU) { const int j = r / I_GLU; transpose_item(inptr(25) + (size_t)j * DM * 4096, DM, 4096, (bf16*)(F.ws + WS_W_GLU) + (size_t)j * 4096 * DM, 2048, scr, r % I_GLU, F.lane); continue; } r -= 2 * I_GLU;
        if (r < 4 * I_FIN) { const int j = r / I_FIN; transpose_item(inptr(10) + (size_t)j * DM * 2 * FF, DM, 2 * FF, (bf16*)(F.ws + WS_W_FIN) + (size_t)j * 2 * FF * DM, FF, scr, r % I_FIN, F.lane); continue; } r -= 4 * I_FIN;
        { const int j = r / I_FOUT; transpose_item(inptr(11) + (size_t)j * FF * DM, FF, DM, (bf16*)(F.ws + WS_W_FOUT) + (size_t)j * DM * FF, 0, scr, r % I_FOUT, F.lane); }
    }
    {
        float* rot = (float*)(F.ws + WS_ROT);
        for (int e = F.gw * 64 + F.lane; e < T_PROMPT * 16; e += F.NGW * 64) {
            const int t = e >> 4, i = e & 15;
            double fr = 1.0;
            switch (i) { case 1: fr = 0.44036660267178046; break; case 2: fr = 0.19392274474868576; break; case 3: fr = 0.08539710028576561; break; case 4: fr = 0.03760603093086393; break;
                case 5: fr = 0.016560440080994446; break; case 6: fr = 0.007292664737217109; break; case 7: fr = 0.003211445994752591; break; case 8: fr = 0.001414213562373095; break;
                case 9: fr = 0.000622772421914596; break; case 10: fr = 0.0002742481756762073; break; case 11: fr = 0.00012076973741146504; break; case 12: fr = 5.318295896944988e-05; break;
                case 13: fr = 2.341999896140934e-05; break; case 14: fr = 1.031338537721246e-05; break; case 15: fr = 4.5416704806078695e-06; break; default: break; }
            const double ang = (double)t * fr;
            const double n = __builtin_rint(ang * 0.15915494309189535);
            double x = __builtin_fma(-n, 6.283185307179586, ang); x = __builtin_fma(-n, 2.4492935982947064e-16, x);
            const double x2 = x * x;
            double cs = 2.4795962632247972e-27, sn = 9.183689863795546e-29;
            cs = __builtin_fma(cs, -x2, 1.6117375710961184e-24); sn = __builtin_fma(sn, -x2, 6.446950284384474e-26);
            cs = __builtin_fma(cs, -x2, 8.896791392450574e-22);  sn = __builtin_fma(sn, -x2, 3.8681701706306835e-23);
            cs = __builtin_fma(cs, -x2, 4.110317623312165e-19);  sn = __builtin_fma(sn, -x2, 1.9572941063391263e-20);
            cs = __builtin_fma(cs, -x2, 1.5619206968586225e-16); sn = __builtin_fma(sn, -x2, 8.22063524662433e-18);
            cs = __builtin_fma(cs, -x2, 4.779477332387385e-14);  sn = __builtin_fma(sn, -x2, 2.8114572543455206e-15);
            cs = __builtin_fma(cs, -x2, 1.1470745597729725e-11); sn = __builtin_fma(sn, -x2, 7.647163731819816e-13);
            cs = __builtin_fma(cs, -x2, 2.08767569878681e-09);   sn = __builtin_fma(sn, -x2, 1.6059043836821613e-10);
            cs = __builtin_fma(cs, -x2, 2.755731922398589e-07);  sn = __builtin_fma(sn, -x2, 2.505210838544172e-08);
            cs = __builtin_fma(cs, -x2, 2.48015873015873e-05);   sn = __builtin_fma(sn, -x2, 2.7557319223985893e-06);
            cs = __builtin_fma(cs, -x2, 0.001388888888888889);   sn = __builtin_fma(sn, -x2, 0.0001984126984126984);
            cs = __builtin_fma(cs, -x2, 0.041666666666666664);   sn = __builtin_fma(sn, -x2, 0.008333333333333333);
            cs = __builtin_fma(cs, -x2, 0.5);                    sn = __builtin_fma(sn, -x2, 0.16666666666666666);
            cs = __builtin_fma(cs, -x2, 1.0);                    sn = __builtin_fma(sn, -x2, 1.0);
            sn = sn * x;
            rot[2 * e] = (float)cs; rot[2 * e + 1] = (float)sn;
        }
    }
    __syncthreads();
    {
        LAS float* sil = (LAS float*)F.lds;
        LAS float* red = (LAS float*)(F.lds + 81920);
        const int nunits = NLAYER * 48;
        if (F.vcu < nunits) {
            for (int i = F.tid; i < NSEQ * DM; i += NWAVES * 64) { const int s = i >> 11, k = i & (DM - 1); const float c = (s < 2) ? inptr(2)[s * DM + k] : inptr(3)[(s - 2) * DM + k]; sil[i] = c * __builtin_amdgcn_rcpf(1.0f + __expf(-c)); }
        }
        __syncthreads();
        for (int unit = F.vcu; unit < nunits; unit += F.G) {
            const int li = unit / 48, cbk = unit % 48, col = cbk * 256 + F.lane * 4;
            f32x4 acc[NSEQ];
#pragma unroll
            for (int s = 0; s < NSEQ; ++s) acc[s] = (f32x4){0.f, 0.f, 0.f, 0.f};
            const float* W = inptr(4) + ((size_t)li * DM + F.wave * 256) * 12288 + col;
#pragma unroll 4
            for (int kk = 0; kk < 256; ++kk) { const f32x4 w4 = *(const f32x4*)(W + (size_t)kk * 12288); const int k = F.wave * 256 + kk;
#pragma unroll
                for (int s = 0; s < NSEQ; ++s) acc[s] += sil[s * DM + k] * w4; }
#pragma unroll 1
            for (int rr = 0; rr < 2; ++rr) {
                __syncthreads();
#pragma unroll
                for (int s5 = 0; s5 < 5; ++s5)
#pragma unroll
                    for (int j = 0; j < 4; ++j) red[(F.wave * 20 + s5 * 4 + j) * 64 + F.lane] = rr ? acc[5 + s5][j] : acc[s5][j];
                __syncthreads();
                for (int i = F.tid; i < 20 * 64; i += NWAVES * 64) { float v = 0.f;
#pragma unroll
                    for (int w = 0; w < 8; ++w) v += red[w * 1280 + i];
                    const int sj = i >> 6, ln = i & 63, s = rr * 5 + (sj >> 2), j = sj & 3, cc = cbk * 256 + ln * 4 + j;
                    ((float*)(F.ws + WS_ADA))[((size_t)li * NSEQ + s) * 12288 + cc] = v + inptr(5)[li * 12288 + cc]; }
            }
        }
    }
}

template <int MODE> __device__ __forceinline__ void norm_block(const float* ADA, const bf16* MIX, bf16* H, bf16* XB, float* OUT, int lane, int m0, int nrows, int lpost, int spost, int lpre, int spre) {
    int cur_s = -1; float A[32], Bm[32], Cs[32];
#pragma unroll
    for (int i = 0; i < 32; ++i) { A[i] = 0.f; Bm[i] = 0.f; Cs[i] = 0.f; }
#pragma unroll 1
    for (int rr = 0; rr < nrows; ++rr) {
        const int m = m0 + rr; const int s = seq_of_row(m);
        if (s != cur_s) {
            cur_s = s;
#pragma unroll
            for (int j = 0; j < 8; ++j) { const int c = 256 * j + 4 * lane;
                if (MODE != 0) { const f32x4 gt = *(const f32x4*)(ADA + ((size_t)lpost * NSEQ + s) * 12288 + (spost ? 5 : 2) * DM + c); const f32x4 gp = *(const f32x4*)(inptr(spost ? 9 : 7) + lpost * DM + c);
#pragma unroll
                    for (int e = 0; e < 4; ++e) A[4 * j + e] = gt[e] * gp[e]; }
                if (MODE != 2) { const f32x4 sh = *(const f32x4*)(ADA + ((size_t)lpre * NSEQ + s) * 12288 + (spre ? 3 : 0) * DM + c); const f32x4 sc = *(const f32x4*)(ADA + ((size_t)lpre * NSEQ + s) * 12288 + (spre ? 4 : 1) * DM + c);
                    const f32x4 gq = *(const f32x4*)(inptr(spre ? 8 : 6) + lpre * DM + c);
#pragma unroll
                    for (int e = 0; e < 4; ++e) { Bm[4 * j + e] = gq[e] * (1.0f + sc[e]); Cs[4 * j + e] = sh[e]; } }
                asm volatile("" ::: "memory");
            }
        }
        f32x4 xv[8];
        if (MODE == 0) { const float* xin = (m < ROWS_PROMPT ? inptr(0) + (size_t)m * DM : inptr(1) + (size_t)(m - ROWS_PROMPT) * DM);
#pragma unroll
            for (int j = 0; j < 8; ++j) xv[j] = *(const f32x4*)(xin + 256 * j + 4 * lane); }
        else {
#pragma unroll
            for (int j = 0; j < 8; ++j) { const v2u xw = __builtin_nontemporal_load((const v2u*)(XB + (size_t)m * DM + 256 * j + 4 * lane)); xv[j] = (f32x4){bf_lo(xw.x), bf_hi(xw.x), bf_lo(xw.y), bf_hi(xw.y)}; } }
        if (MODE != 0) {
            v2u mv[8]; float ss = 0.f;
#pragma unroll
            for (int j = 0; j < 8; ++j) mv[j] = __builtin_nontemporal_load((const v2u*)(MIX + (size_t)m * DM + 256 * j + 4 * lane));
            float mf[32];
#pragma unroll
            for (int j = 0; j < 8; ++j) { mf[4 * j] = bf_lo(mv[j].x); mf[4 * j + 1] = bf_hi(mv[j].x); mf[4 * j + 2] = bf_lo(mv[j].y); mf[4 * j + 3] = bf_hi(mv[j].y); }
#pragma unroll
            for (int i = 0; i < 32; ++i) ss += mf[i] * mf[i];
            ss = wave_sum(ss); const float rstd = __builtin_amdgcn_rsqf(ss * (1.0f / DM) + NORM_EPS);
#pragma unroll
            for (int j = 0; j < 8; ++j)
#pragma unroll
                for (int e = 0; e < 4; ++e) xv[j][e] += A[4 * j + e] * (mf[4 * j + e] * rstd);
        }
        if (MODE == 2) { float* xo = OUT + (size_t)m * DM;
#pragma unroll
            for (int j = 0; j < 8; ++j) *(f32x4*)(xo + 256 * j + 4 * lane) = xv[j]; }
        else {
#pragma unroll
            for (int j = 0; j < 8; ++j) { v2u w; w.x = pk2(xv[j][0], xv[j][1]); w.y = pk2(xv[j][2], xv[j][3]); __builtin_nontemporal_store(w, (v2u*)(XB + (size_t)m * DM + 256 * j + 4 * lane)); } }
        if (MODE != 2) {
            float s2 = 0.f;
#pragma unroll
            for (int j = 0; j < 8; ++j) s2 += (xv[j][0] * xv[j][0] + xv[j][1] * xv[j][1]) + (xv[j][2] * xv[j][2] + xv[j][3] * xv[j][3]);
            s2 = wave_sum(s2); const float r2 = __builtin_amdgcn_rsqf(s2 * (1.0f / DM) + NORM_EPS);
#pragma unroll
            for (int j = 0; j < 8; ++j) { v2u w;
                w.x = pk2(xv[j][0] * r2 * Bm[4 * j] + Cs[4 * j], xv[j][1] * r2 * Bm[4 * j + 1] + Cs[4 * j + 1]);
                w.y = pk2(xv[j][2] * r2 * Bm[4 * j + 2] + Cs[4 * j + 2], xv[j][3] * r2 * Bm[4 * j + 3] + Cs[4 * j + 3]);
                *(v2u*)(H + (size_t)m * DM + 256 * j + 4 * lane) = w; }
        }
    }
}
template <int MODE> __device__ __forceinline__ void norm_phase(Frame& F, const Args& KA, int lpost, int spost, int lpre, int spre) {
    for (int blk = F.gw; blk < MROWS / 24; blk += F.NGW)
        norm_block<MODE>((const float*)(F.ws + WS_ADA), (const bf16*)(F.ws + WS_MIX), HBUF(F), XBUF(F), F.out, F.lane, blk * 24, 24, lpost, spost, lpre, spre);
}
template <int MODE> struct NormOrder : pg8::StaticOrder {
    unsigned* cnt; volatile LAS unsigned* flag; const float* ADA; const bf16* MIX; bf16* H; bf16* XB; float* OUT; int lpost, spost, lpre, spre, wave, lane;
    __device__ __forceinline__ void done(const pg8::Unit& u) const {
        asm volatile("s_waitcnt vmcnt(0)" ::: "memory");
        asm volatile("" ::: "memory"); __builtin_amdgcn_s_barrier(); asm volatile("" ::: "memory");
        const int gidx = u.pm >> 3; const bool last_of_group = u.pn >= nN - 4;
        if (wave == 0) {
            if (lane == 0) (void)__hip_atomic_fetch_add(cnt + 64 * gidx, 1u, __ATOMIC_RELAXED, __HIP_MEMORY_SCOPE_AGENT);
            if (last_of_group) {
                const unsigned want = 8u * (unsigned)nN; unsigned spins = 0u;
                while ((unsigned)__builtin_amdgcn_readfirstlane(__hip_atomic_load(cnt + 64 * gidx, __ATOMIC_RELAXED, __HIP_MEMORY_SCOPE_AGENT)) < want) { __builtin_amdgcn_s_sleep(2); if (++spins > (1u << 22)) break; }
                __builtin_amdgcn_fence(__ATOMIC_ACQUIRE, "agent"); asm volatile("s_waitcnt vmcnt(0)" ::: "memory");
            }
        }
        if (last_of_group) {
            asm volatile("" ::: "memory"); __builtin_amdgcn_s_barrier(); asm volatile("" ::: "memory");
            norm_block<MODE>(ADA, MIX, H, XB, OUT, lane, 2048 * gidx + 64 * (c >> 3) + 8 * wave, 8, lpost, spost, lpre, spre);
        }
    }
};

__device__ __forceinline__ void rotary_phase(Frame& F) {
    bf16* QKV = (bf16*)(F.ws + WS_BIG); const float* rot = (const float*)(F.ws + WS_ROT);
    const int total = MROWS * 32;
    for (int i = F.gw * 64 + F.lane; i < total; i += F.NGW * 64) {
        const int m = i >> 5, blk = (i >> 1) & 15, hp = i & 1, t = pos_of_row(m);
        bf16* p = QKV + (size_t)m * 6144 + 3072 + blk * 128 + 8 * hp;
        const v4u a = *(const v4u*)p, b = *(const v4u*)(p + 16);
        const f32x4* rt = (const f32x4*)(rot + (size_t)t * 32 + 16 * hp);
        const f32x4 r0 = rt[0], r1 = rt[1], r2 = rt[2], r3 = rt[3];
        const float cs[8] = {r0[0], r0[2], r1[0], r1[2], r2[0], r2[2], r3[0], r3[2]}, sn[8] = {r0[1], r0[3], r1[1], r1[3], r2[1], r2[3], r3[1], r3[3]};
        float x1[8], x2[8], y1[8], y2[8];
#pragma unroll
        for (int e = 0; e < 4; ++e) { x1[2 * e] = bf_lo(a[e]); x1[2 * e + 1] = bf_hi(a[e]); x2[2 * e] = bf_lo(b[e]); x2[2 * e + 1] = bf_hi(b[e]); }
#pragma unroll
        for (int e = 0; e < 8; ++e) { y1[e] = x1[e] * cs[e] - x2[e] * sn[e]; y2[e] = x2[e] * cs[e] + x1[e] * sn[e]; }
        v4u oa, ob;
#pragma unroll
        for (int e = 0; e < 4; ++e) { oa[e] = pk2(y1[2 * e], y1[2 * e + 1]); ob[e] = pk2(y2[2 * e], y2[2 * e + 1]); }
        *(v4u*)p = oa; *(v4u*)(p + 16) = ob;
    }
}

__device__ __forceinline__ void subln_phase(Frame& F, const Args& KA, int j, float one_minus_li) {
    const float* DIFFO = (const float*)(F.ws + WS_MIX); bf16* ATT = ATTBUF(F);
    const float* g = inptr(16) + j * 256;
    const f32x4 gv = *(const f32x4*)(g + 4 * F.lane);
    for (int m = F.gw; m < MROWS; m += F.NGW) {
        f32x4 v[4];
#pragma unroll
        for (int hh = 0; hh < 4; ++hh) v[hh] = *(const f32x4*)(DIFFO + (size_t)m * 1024 + 256 * hh + 4 * F.lane);
#pragma unroll
        for (int hh = 0; hh < 4; ++hh) {
            float ss = (v[hh][0] * v[hh][0] + v[hh][1] * v[hh][1]) + (v[hh][2] * v[hh][2] + v[hh][3] * v[hh][3]);
            ss = wave_sum(ss); const float r = __builtin_amdgcn_rsqf(ss * (1.0f / 256.0f) + NORM_EPS) * one_minus_li;
            v2u w; w.x = pk2(v[hh][0] * r * gv[0], v[hh][1] * r * gv[1]); w.y = pk2(v[hh][2] * r * gv[2], v[hh][3] * r * gv[3]);
            *(v2u*)(ATT + (size_t)m * DM + 1024 + 256 * hh + 4 * F.lane) = w;
        }
    }
}

#ifndef ATT_DYN
#define ATT_DYN 1
#endif
__device__ __forceinline__ void attention_phase(Frame& F, const Args& KA, int j, float lambda_init) {
    const bf16* QKV = (const bf16*)(F.ws + WS_BIG); bf16* ATT = ATTBUF(F); float* DIFFO = (float*)(F.ws + WS_MIX);
    float lam;
    { const float* lp = inptr(15) + j * 512; const int l = F.lane;
      float s1 = lp[l] * lp[128 + l] + lp[64 + l] * lp[192 + l], s2 = lp[256 + l] * lp[384 + l] + lp[320 + l] * lp[448 + l];
      s1 = wave_sum(s1); s2 = wave_sum(s2); lam = __expf(s1) - __expf(s2) + lambda_init; lam = __uint_as_float(__builtin_amdgcn_readfirstlane(__float_as_uint(lam))); }
#if ATT_DYN
    { unsigned* qctr = (unsigned*)(F.ws + WS_CTL) + 32768 + 64 * j; volatile LAS unsigned* slot = (volatile LAS unsigned*)(F.lds + LDSCTL_OFF + 1024);
      int tid_na = F.tid; asm volatile("" : "+v"(tid_na));
#pragma unroll 1
      for (int it = 0;; ++it) {
          int t; asm volatile("" : "+v"(tid_na));
          if (it < 2) t = -1;
          else { __syncthreads();
                 if (tid_na == 0) *slot = __hip_atomic_fetch_add(qctr, 1u, __ATOMIC_RELAXED, __HIP_MEMORY_SCOPE_AGENT);
                 __syncthreads();
                 t = (int)__builtin_amdgcn_readfirstlane(*slot);
                 if (t >= 256 + 1536) break; }
          if (t < 256) { int sh, qb, rb, T;
              if (t < 0) { const int u = F.vcu + it * F.G; sh = u >> 6; qb = u & 63; rb = (sh >> 2) * T_PROMPT; T = T_PROMPT; }
              else { sh = t >> 3; qb = t & 7; rb = ROWS_PROMPT + (sh >> 2) * T_SAMPLE; T = T_SAMPLE; }
              at::diff_unit16(QKV, DIFFO, j, rb, T, sh & 3, qb, lam, F.ldsg, F.lds, tid_na); }
          else { const int nu = t - 256, h = nu / 192, bg = nu % 192; int rb, rows, band;
              if (bg < 128) { rb = (bg >> 6) * T_PROMPT; rows = T_PROMPT / 64; band = bg & 63; } else { const int bs = bg - 128; rb = ROWS_PROMPT + (bs >> 3) * T_SAMPLE; rows = T_SAMPLE / 64; band = bs & 7; }
              at::na_unit(QKV, ATT, inptr(14) + ((size_t)j * 8 + h) * 465, rb, rows, h, band, F.ldsg, tid_na); } } }
#else
#ifndef NO_DIFF
#if MERGED_V
#pragma unroll 1
    for (int u = F.vcu; u < 768; u += F.G) {
        int sh, qb, rb, T;
        if (u < 512) { sh = u >> 6; qb = u & 63; rb = (sh >> 2) * T_PROMPT; T = T_PROMPT; }
        else { const int su = u - 512; sh = su >> 3; qb = su & 7; rb = ROWS_PROMPT + (sh >> 2) * T_SAMPLE; T = T_SAMPLE; }
#if ATT16
        at::diff_unit16(QKV, DIFFO, j, rb, T, sh & 3, qb, lam, F.ldsg, F.lds, F.tid);
#else
        at::diff_unit2(QKV, DIFFO, rb, T, sh & 3, qb, lam, F.ldsg, F.lds, F.tid);
#endif
    }
#else
#pragma unroll 1
    for (int u = F.vcu; u < 1536; u += F.G) {
        int combo, qb, rb, T;
        if (u < 1024) { combo = u >> 6; qb = u & 63; rb = (combo >> 3) * T_PROMPT; T = T_PROMPT; }
        else { const int su = u - 1024; combo = su >> 3; qb = su & 7; rb = ROWS_PROMPT + (combo >> 3) * T_SAMPLE; T = T_SAMPLE; }
        at::diff_unit(QKV, DIFFO, rb, T, (combo >> 1) & 3, qb, combo & 1, lam, F.ldsg, F.tid);
    }
#endif
#endif
#ifndef NO_NA
    { const int per = (1536 + F.G - 1) / F.G; int tid_na = F.tid; asm volatile("" : "+v"(tid_na));
      for (int i = 0; i < per; ++i) { const int nu = F.vcu * per + i; if (nu >= 1536) break;
          const int h = nu / 192, bg = nu % 192; int rb, rows, band;
          if (bg < 128) { rb = (bg >> 6) * T_PROMPT; rows = T_PROMPT / 64; band = bg & 63; } else { const int bs = bg - 128; rb = ROWS_PROMPT + (bs >> 3) * T_SAMPLE; rows = T_SAMPLE / 64; band = bs & 7; }
          at::na_unit(QKV, ATT, inptr(14) + ((size_t)j * 8 + h) * 465, rb, rows, h, band, F.ldsg, tid_na); } }
#endif
#endif
}

typedef float s5f2 __attribute__((ext_vector_type(2)));
__device__ __forceinline__ void s5_st_nt(float2* p, float a, float b) { const s5f2 v = {a, b}; __builtin_nontemporal_store(v, (s5f2*)p); }
__device__ __forceinline__ float2 s5_ld_nt(const float2* p) { const s5f2 v = __builtin_nontemporal_load((const s5f2*)p); return make_float2(v[0], v[1]); }
struct S5Lam { float lr, li, cr, ci; };
__device__ __forceinline__ S5Lam s5_lambda(const Args& KA, int j, int dir, int g, int p) {
    const int gi = (j * 2 + dir) * 128 + g;
    const float are = inptr(17)[gi * 64 + p], aim = inptr(18)[gi * 64 + p], dt = __expf(inptr(19)[gi]);
    const float xr = are * dt, th = aim * dt;
    const float ex = __expf(xr), em1 = expm1f(xr), sn = sinf(th), cs = cosf(th), sh = sinf(0.5f * th);
    S5Lam L; L.lr = ex * cs; L.li = ex * sn;
    const float nr = em1 * cs - 2.0f * sh * sh, ni = L.li;
    const float den = 1.0f / (are * are + aim * aim);
    L.cr = (nr * are + ni * aim) * den; L.ci = (ni * are - nr * aim) * den;
    return L;
}
__device__ __forceinline__ void s5_tables(Frame& F, const Args& KA) {
    f32x4* LAM = (f32x4*)(F.ws + WS_S5LAM); float2* L64 = (float2*)(F.ws + WS_S5L64); bf16* BOP = (bf16*)(F.ws + WS_S5BOP); bf16* COP = (bf16*)(F.ws + WS_S5COP);
    for (int combo = F.gw; combo < 512; combo += F.NGW) {
        const int p = F.lane, j = combo >> 8, dir = (combo >> 7) & 1, g = combo & 127;
        const S5Lam L = s5_lambda(KA, j, dir, g, p);
        LAM[combo * 64 + p] = (f32x4){L.lr, L.li, L.cr, L.ci};
        float pr = L.lr, pi = L.li;
#pragma unroll
        for (int i = 0; i < 6; ++i) { const float nr = pr * pr - pi * pi, ni = 2.0f * pr * pi; pr = nr; pi = ni; }
        L64[combo * 64 + p] = make_float2(pr, pi);
        const size_t bo = ((size_t)combo * 64 + p) * 16;
        v4u wr[2], wi[2];
#pragma unroll
        for (int h8 = 0; h8 < 2; ++h8) {
            const f32x4 br0 = *(const f32x4*)(inptr(20) + bo + 8 * h8), br1 = *(const f32x4*)(inptr(20) + bo + 8 * h8 + 4), bi0 = *(const f32x4*)(inptr(21) + bo + 8 * h8), bi1 = *(const f32x4*)(inptr(21) + bo + 8 * h8 + 4);
            wr[h8].x = pk2(L.cr * br0[0] - L.ci * bi0[0], L.cr * br0[1] - L.ci * bi0[1]); wr[h8].y = pk2(L.cr * br0[2] - L.ci * bi0[2], L.cr * br0[3] - L.ci * bi0[3]);
            wr[h8].z = pk2(L.cr * br1[0] - L.ci * bi1[0], L.cr * br1[1] - L.ci * bi1[1]); wr[h8].w = pk2(L.cr * br1[2] - L.ci * bi1[2], L.cr * br1[3] - L.ci * bi1[3]);
            wi[h8].x = pk2(L.cr * bi0[0] + L.ci * br0[0], L.cr * bi0[1] + L.ci * br0[1]); wi[h8].y = pk2(L.cr * bi0[2] + L.ci * br0[2], L.cr * bi0[3] + L.ci * br0[3]);
            wi[h8].z = pk2(L.cr * bi1[0] + L.ci * br1[0], L.cr * bi1[1] + L.ci * br1[1]); wi[h8].w = pk2(L.cr * bi1[2] + L.ci * br1[2], L.cr * bi1[3] + L.ci * br1[3]);
        }
        v4u* bre = (v4u*)(BOP + (((size_t)combo * 2 + 0) * 64 + p) * 16); v4u* bim = (v4u*)(BOP + (((size_t)combo * 2 + 1) * 64 + p) * 16);
        bre[0] = wr[0]; bre[1] = wr[1]; bim[0] = wi[0]; bim[1] = wi[1];
        { const int c = p >> 2, p0 = 16 * (p & 3); const size_t co = ((size_t)combo * 16 + c) * 64 + p0;
          v4u* dst = (v4u*)(COP + ((size_t)combo * 16 + c) * 128 + 2 * p0);
#pragma unroll
          for (int q4 = 0; q4 < 4; ++q4) { const f32x4 cr4 = *(const f32x4*)(inptr(22) + co + 4 * q4), ci4 = *(const f32x4*)(inptr(23) + co + 4 * q4);
              v4u w; w.x = pk2(cr4[0], -ci4[0]); w.y = pk2(cr4[1], -ci4[1]); w.z = pk2(cr4[2], -ci4[2]); w.w = pk2(cr4[3], -ci4[3]); dst[q4] = w; } }
    }
}
struct S5L2 { float lr, li; };
__device__ __forceinline__ S5L2 s5_lam_ld(const Frame& F, int combo, int p) { const f32x4 v = ((const f32x4*)(F.ws + WS_S5LAM))[combo * 64 + p]; S5L2 L; L.lr = v[0]; L.li = v[1]; return L; }
__device__ __forceinline__ void s5_bop_ld(const Frame& F, int combo, int p, int hi, bf16x8& re, bf16x8& im) {
    const bf16* B = (const bf16*)(F.ws + WS_S5BOP);
    re = *(const bf16x8*)(B + (((size_t)combo * 2 + 0) * 64 + p) * 16 + 8 * hi); im = *(const bf16x8*)(B + (((size_t)combo * 2 + 1) * 64 + p) * 16 + 8 * hi);
}
#define S5_PIN(v) asm volatile("" : "+v"(v))
#define S5_STEP(xr, xi, L, br, bi) do { float _t1 = fmaf(-L.li, xi, br); S5_PIN(_t1); float _nr = fmaf(L.lr, xr, _t1); S5_PIN(_nr); float _t2 = fmaf(L.li, xr, bi); S5_PIN(_t2); float _ni = fmaf(L.lr, xi, _t2); S5_PIN(_ni); xr = _nr; xi = _ni; } while (0)

__device__ __forceinline__ void s5_phaseA(Frame& F, const Args& KA, int j) {
    const bf16* H = HBUF(F); float2* E = (float2*)(F.ws + WS_S5E);
    const int r32 = F.lane & 31, hi = F.lane >> 5;
    const int half_i = (r32 >> 2) & 1, r_i = (r32 & 3) + 4 * (r32 >> 3);
    int prev_pair = -1; S5L2 L0, L1; bf16x8 Bop[4];
    L0.lr = L0.li = 0.f; L1 = L0;
#pragma unroll
    for (int k = 0; k < 4; ++k) Bop[k] = (bf16x8){0, 0, 0, 0, 0, 0, 0, 0};
    for (int tk = F.gw; tk < 256 * (S5_NCH / 2); tk += F.NGW) {
        const int pair = tk & 255, q = tk >> 8, g = pair >> 1, dir = pair & 1;
        if (pair != prev_pair) { prev_pair = pair; const int combo = (j * 2 + dir) * 128 + g; L0 = s5_lam_ld(F, combo, r32); L1 = s5_lam_ld(F, combo, 32 + r32);
            s5_bop_ld(F, combo, r32, hi, Bop[0], Bop[1]); s5_bop_ld(F, combo, 32 + r32, hi, Bop[2], Bop[3]); }
        float x0r = 0.f, x0i = 0.f, x1r = 0.f, x1i = 0.f;
        const int tt = dir ? 15 - r_i : r_i;
        const bf16* hp = H + (size_t)(64 * (2 * q + half_i) + tt) * DM + 16 * g + 8 * hi;
        bf16x8 a[4];
#pragma unroll
        for (int bb = 0; bb < 4; ++bb) { const int b = dir ? 3 - bb : bb; a[bb] = *(const bf16x8*)(hp + (size_t)(16 * b) * DM); }
#pragma unroll
        for (int bb = 0; bb < 4; ++bb) {
            f32x16 d0 = __builtin_amdgcn_mfma_f32_32x32x16_bf16(a[bb], Bop[0], (f32x16){}, 0, 0, 0), d1 = __builtin_amdgcn_mfma_f32_32x32x16_bf16(a[bb], Bop[1], (f32x16){}, 0, 0, 0);
            f32x16 d2 = __builtin_amdgcn_mfma_f32_32x32x16_bf16(a[bb], Bop[2], (f32x16){}, 0, 0, 0), d3 = __builtin_amdgcn_mfma_f32_32x32x16_bf16(a[bb], Bop[3], (f32x16){}, 0, 0, 0);
#pragma unroll
            for (int r = 0; r < 16; ++r) { S5_STEP(x0r, x0i, L0, d0[r], d1[r]); S5_STEP(x1r, x1i, L1, d2[r], d3[r]); }
        }
        float2* e = E + ((size_t)((dir * 128 + g) * S5_NCH) + 2 * q + hi) * 64;
        s5_st_nt(e + r32, x0r, x0i); s5_st_nt(e + 32 + r32, x1r, x1i);
    }
}

__device__ __forceinline__ void s5_carry_task(Frame& F, const Args& KA, int j, int tk) {
    const float2* E = (const float2*)(F.ws + WS_S5E); float2* X = (float2*)(F.ws + WS_S5X);
    int dg, c0, nc;
    if (tk < 512) { dg = tk & 255; c0 = (tk >> 8) * (T_PROMPT / S5_L); nc = T_PROMPT / S5_L; }
    else { const int t2 = tk - 512; dg = t2 & 255; c0 = ROWS_PROMPT / S5_L + (t2 >> 8) * (T_SAMPLE / S5_L); nc = T_SAMPLE / S5_L; }
    const int dir = dg >> 7, g = dg & 127, p = F.lane;
    const float2 l64 = ((const float2*)(F.ws + WS_S5L64))[((j * 2 + dir) * 128 + g) * 64 + p]; const float pr = l64.x, pi = l64.y;
    const size_t base = (size_t)dg * S5_NCH * 64 + p;
    float cr = 0.f, ci = 0.f;
    for (int k0 = 0; k0 < nc; k0 += 32) {
        float2 e[32];
#pragma unroll
        for (int i = 0; i < 32; ++i) { const int c = dir ? (c0 + nc - 1 - (k0 + i)) : (c0 + k0 + i); e[i] = s5_ld_nt(E + base + (size_t)c * 64); }
#pragma unroll
        for (int i = 0; i < 32; ++i) { const int c = dir ? (c0 + nc - 1 - (k0 + i)) : (c0 + k0 + i); s5_st_nt(X + base + (size_t)c * 64, cr, ci);
            const float nr = fmaf(pr, cr, fmaf(-pi, ci, e[i].x)), ni = fmaf(pr, ci, fmaf(pi, cr, e[i].y)); cr = nr; ci = ni; }
    }
}
__device__ __forceinline__ void s5_phaseB(Frame& F, const Args& KA, int j) {
    const int gw = F.gw;
#pragma unroll 1
    for (int i = 0; i < 2; ++i) {
        int tk;
        if (F.NGW >= 2048) { if (i == 0) tk = gw; else tk = (gw >= 512 && gw < 1024) ? 2048 + (gw - 512) : -1; if (gw >= 2048) tk = -1; }
        else tk = -2;
        if (tk >= 0) s5_carry_task(F, KA, j, tk);
        if (tk == -2) { if (i == 0) for (int t2 = gw; t2 < 2560; t2 += F.NGW) s5_carry_task(F, KA, j, t2); }
    }
}

template <int DIR> __device__ __forceinline__ void s5c_dir(Frame& F, const Args& KA, int j, int g, int q, LAS unsigned char* tile, f32x16 (&Y)[4]) {
    const bf16* H = HBUF(F); const float2* X = (const float2*)(F.ws + WS_S5X);
    const int r32 = F.lane & 31, hi = F.lane >> 5;
    const int half_i = (r32 >> 2) & 1, r_i = (r32 & 3) + 4 * (r32 >> 3);
    const int combo = (j * 2 + DIR) * 128 + g;
    const S5L2 L0 = s5_lam_ld(F, combo, r32), L1 = s5_lam_ld(F, combo, 32 + r32);
    bf16x8 Bop[4]; s5_bop_ld(F, combo, r32, hi, Bop[0], Bop[1]); s5_bop_ld(F, combo, 32 + r32, hi, Bop[2], Bop[3]);
    LAS unsigned char* cop = tile + 8704;
    if (r32 < 16) {
        const v4u* csrc = (const v4u*)((const bf16*)(F.ws + WS_S5COP) + ((size_t)combo * 16 + r32) * 128 + 8 * hi);
#pragma unroll
        for (int ks = 0; ks < 8; ++ks) *(LAS v4u*)(cop + (ks * 32 + hi * 16 + r32) * 16) = csrc[2 * ks];
    }
    LDS_WAIT();
    const bf16* hp = H + (size_t)(64 * (2 * q + half_i) + r_i) * DM + 16 * g + 8 * hi;
    if (DIR == 0) {
        bf16x8 Dhi = (bf16x8){0, 0, 0, 0, 0, 0, 0, 0}, Dlo = Dhi;
        const float d = (r32 < 16) ? inptr(24)[j * DM + 16 * g + r32] : 0.f;
        const unsigned dh = pk2(d, 0.f) & 0xffffu; const float dhf = __uint_as_float(dh << 16); const unsigned dl = pk2(d - dhf, 0.f) & 0xffffu;
#pragma unroll
        for (int e = 0; e < 8; ++e) { const bool on = (8 * hi + e) == r32; Dhi[e] = on ? (short)dh : (short)0; Dlo[e] = on ? (short)dl : (short)0; }
#pragma unroll
        for (int b = 0; b < 4; ++b) { const bf16x8 ab = *(const bf16x8*)(hp + (size_t)(16 * b) * DM);
            Y[b] = __builtin_amdgcn_mfma_f32_32x32x16_bf16(ab, Dhi, Y[b], 0, 0, 0); Y[b] = __builtin_amdgcn_mfma_f32_32x32x16_bf16(ab, Dlo, Y[b], 0, 0, 0); }
        asm volatile("" ::: "memory");
    }
    float x0r, x0i, x1r, x1i;
    { const float2* xp = X + ((size_t)((DIR * 128 + g) * S5_NCH) + 2 * q + hi) * 64; const float2 a = s5_ld_nt(xp + r32), b = s5_ld_nt(xp + 32 + r32); x0r = a.x; x0i = a.y; x1r = b.x; x1i = b.y; }
    bf16x8 an = *(const bf16x8*)(hp + (size_t)(16 * (DIR ? 3 : 0)) * DM);
#pragma unroll
    for (int bb = 0; bb < 4; ++bb) {
        const int b = DIR ? 3 - bb : bb;
        bf16x8 a[4]; a[b] = an; if (bb < 3) an = *(const bf16x8*)(hp + (size_t)(16 * (DIR ? 2 - bb : bb + 1)) * DM);
        f32x16 d0 = __builtin_amdgcn_mfma_f32_32x32x16_bf16(a[b], Bop[0], (f32x16){}, 0, 0, 0), d1 = __builtin_amdgcn_mfma_f32_32x32x16_bf16(a[b], Bop[1], (f32x16){}, 0, 0, 0);
        f32x16 d2 = __builtin_amdgcn_mfma_f32_32x32x16_bf16(a[b], Bop[2], (f32x16){}, 0, 0, 0), d3 = __builtin_amdgcn_mfma_f32_32x32x16_bf16(a[b], Bop[3], (f32x16){}, 0, 0, 0);
#pragma unroll
        for (int rr = 0; rr < 16; ++rr) { const int r = DIR ? 15 - rr : rr;
            S5_STEP(x0r, x0i, L0, d0[r], d1[r]); S5_STEP(x1r, x1i, L1, d2[r], d3[r]);
            const int row = (r & 3) + 8 * (r >> 2) + 4 * hi;
            *(LAS unsigned*)(tile + row * 272 + 4 * r32) = pk2(x0r, x0i);
            *(LAS unsigned*)(tile + row * 272 + 128 + 4 * r32) = pk2(x1r, x1i); }
        LDS_WAIT();
#pragma unroll
        for (int ks = 0; ks < 8; ++ks) { const bf16x8 xa = *(const LAS bf16x8*)(tile + r32 * 272 + (16 * ks + 8 * hi) * 2);
            v4u cw = *(const LAS v4u*)(cop + (ks * 32 + hi * 16 + (r32 & 15)) * 16); if (r32 >= 16) cw = (v4u){0u, 0u, 0u, 0u};
            Y[b] = __builtin_amdgcn_mfma_f32_32x32x16_bf16(xa, __builtin_bit_cast(bf16x8, cw), Y[b], 0, 0, 0); }
        LDS_WAIT();
    }
}

__device__ __forceinline__ void s5_phaseC(Frame& F, const Args& KA, int j) {
    bf16* ATT = ATTBUF(F);
    LAS unsigned char* tile = F.lds + F.wave * 12800;
    const int r32 = F.lane & 31, hi = F.lane >> 5;
    for (int tk = F.gw; tk < 128 * (S5_NCH / 2); tk += F.NGW) {
        const int g = tk & 127, q = tk >> 7;
        f32x16 Y[4];
#pragma unroll
        for (int b = 0; b < 4; ++b) Y[b] = (f32x16){};
        s5c_dir<0>(F, KA, j, g, q, tile, Y);
        s5c_dir<1>(F, KA, j, g, q, tile, Y);
        if (r32 < 16) {
            bf16* op = ATT + (size_t)(64 * (2 * q + hi)) * DM + 16 * g + r32;
#pragma unroll
            for (int b = 0; b < 4; ++b)
#pragma unroll
                for (int r = 0; r < 16; ++r) { const float x = Y[b][r]; const float z = 0.7978845608028654f * (x + 0.044715f * x * x * x);
                    const float y = x * __builtin_amdgcn_rcpf(1.0f + __builtin_amdgcn_exp2f(-2.8853900817779268f * z));
                    op[(size_t)(16 * b + r) * DM] = (bf16)(pk2(y, 0.f) & 0xffffu); }
        }
    }
}

#ifndef MK_PER_PHASE
#define MK_PER_PHASE 0
#endif
#ifndef EN_ALL
#define EN_ALL 1
#endif
#ifndef EN_P0
#define EN_P0 EN_ALL
#endif
#ifndef EN_NORM
#define EN_NORM EN_ALL
#endif
#ifndef EN_GEMM
#define EN_GEMM EN_ALL
#endif
#ifndef EN_ROT
#define EN_ROT EN_ALL
#endif
#ifndef EN_ATT
#define EN_ATT EN_ALL
#endif
#ifndef EN_SUB
#define EN_SUB EN_ALL
#endif
#ifndef EN_S5A
#define EN_S5A EN_ALL
#endif
#ifndef EN_S5B
#define EN_S5B EN_ALL
#endif
#ifndef EN_S5C
#define EN_S5C EN_ALL
#endif
#ifndef FUSE_NORM
#define FUSE_NORM 0
#endif
constexpr int PH_PER_LAYER = 9, N_PHASES = 2 + NLAYER * PH_PER_LAYER;

__global__ void __launch_bounds__(NWAVES * 64, 2) trunk_fwd(Args args) {
    extern __shared__ __attribute__((aligned(16))) unsigned char lds[];
    Frame F;
    F.lds = (LAS unsigned char*)lds; F.ldsg = (char*)lds;
    F.wave = __builtin_amdgcn_readfirstlane((int)threadIdx.x >> 6); F.lane = (int)xb_lane(); F.tid = F.wave * 64 + F.lane;
    F.G = gridDim.x; { const int bx = blockIdx.x; F.vcu = (F.G % 8 == 0) ? (bx % 8) * (F.G / 8) + bx / 8 : bx; }
    F.gw = blockIdx.x * NWAVES + F.wave; F.NGW = F.G * NWAVES;
    F.out = args.out; F.ws = args.ws;
    volatile LAS unsigned* MISC = (volatile LAS unsigned*)(F.lds + MISC_OFF);
    for (int u = F.tid; u < (LDS_BYTES - LDSCTL_OFF) / 4; u += NWAVES * 64) ((LAS unsigned*)(F.lds + LDSCTL_OFF))[u] = 0u;
    __syncthreads();
    const int lo = args.ph_lo, hi = args.ph_hi;
    XcdBarrier bar; bar.wave = (unsigned)F.wave; bar.bar = (unsigned*)(F.ws + WS_CTL) + CW_BAR; bar.x = 0; bar.st = nullptr;
    if (!MK_PER_PHASE || hi - lo > 1) bar = xcd_barrier_post((unsigned*)(F.ws + WS_CTL) + CW_BAR, MISC + 8, (unsigned)F.wave);
#define REFRESH() do { int _t = (int)xb_lane(); asm volatile("" : "+v"(_t)); F.lane = _t; F.tid = F.wave * 64 + _t; unsigned _l = 0; asm volatile("" : "+s"(_l)); F.ws = args.ws + _l; F.out = args.out + _l; \
    F.lds = (LAS unsigned char*)lds + _l; F.ldsg = (char*)lds + _l; } while (0)
#ifndef HREP_P0
#define HREP_P0 1
#endif
#ifndef HREP_P1
#define HREP_P1 1
#endif
#ifndef HREP_FIN
#define HREP_FIN 1
#endif
#ifndef HREP_FOUT
#define HREP_FOUT 1
#endif
#ifndef HREP_INP
#define HREP_INP 1
#endif
#ifndef HREP_OUTP
#define HREP_OUTP 1
#endif
#ifndef HREP_GLU
#define HREP_GLU 1
#endif
#ifndef HREP_ATT
#define HREP_ATT 1
#endif
#ifndef HREP_S5
#define HREP_S5 1
#endif
#ifndef REP_GEMM
#define REP_GEMM 1
#endif
#ifndef REP_ATT
#define REP_ATT 1
#endif
#ifndef REP_S5
#define REP_S5 1
#endif
#ifndef REP_P0
#define REP_P0 1
#endif
#ifndef REP_SMALL
#define REP_SMALL 1
#endif
#define REPEAT(n) _Pragma("unroll 1") for (int rep_ = 0; rep_ < (n); ++rep_)
#ifndef DBG_STOP
#define DBG_STOP 1000
#endif
#ifndef DBG_DUMP
#define DBG_DUMP 0
#endif
#ifndef DBG_FIRST_LAYER
#define DBG_FIRST_LAYER 0
#endif
#if MK_PER_PHASE
#define IN(k) (lo <= (k) && (k) < hi && (k) <= DBG_STOP)
#define SEAM(k) do { if (lo <= (k) && (k) + 1 < hi) xcd_barrier(bar); } while (0)
#define SEAM2(k) do { if (lo <= (k) && (k) + 2 < hi) xcd_barrier(bar); } while (0)
#else
#define IN(k) ((k) <= DBG_STOP)
#define SEAM(k) xcd_barrier(bar)
#define SEAM2(k) xcd_barrier(bar)
#endif
#define MK_NORM_ORDER(S, MODE_, bank, lpost_, spost_, lpre_, spre_) NormOrder<MODE_> S; S.init(MROWS, DM == 0 ? 0 : S_N, F.G, (int)blockIdx.x); \
    S.cnt = (unsigned*)(args.ws + WS_CTL) + CW_NORM + (bank) * NORM_BANK; S.flag = MISC + 16; S.ADA = (const float*)(F.ws + WS_ADA); S.MIX = (const bf16*)(F.ws + WS_MIX); S.H = HBUF(F); S.XB = XBUF(F); S.OUT = F.out; \
    S.lpost = (lpost_); S.spost = (spost_); S.lpre = (lpre_); S.spre = (spre_); S.wave = F.wave; S.lane = F.lane
#define OUTP(eoff) ({ unsigned _z = 0; asm volatile("" : "+s"(_z)); (bf16*)args.out + _z + (size_t)(eoff); })
#define WSP(off) ({ unsigned _z = 0; asm volatile("" : "+s"(_z)); (bf16*)(args.ws + _z + (off)); })

    if (EN_P0 && IN(0)) { REFRESH(); p0_prologue(F, args); s5_tables(F, args); } SEAM(0);
    if (EN_NORM && IN(1)) { REFRESH(); norm_phase<0>(F, args, 0, 0, 0, 0); } SEAM(1);
#pragma unroll 1
    for (int li = DBG_FIRST_LAYER; li < NLAYER; ++li) {
        const int base = 2 + li * PH_PER_LAYER, j = li >> 1;
        if ((li & 1) == 0) {
            if (EN_GEMM && IN(base + 0)) { REFRESH();
                pg8::Gemm g{OUTP(0), WSP(WS_W_AIN) + (size_t)j * 6144 * DM, MROWS, 6144, DM}; pg8::StaticOrder S; S.init(MROWS, 6144, F.G, (int)blockIdx.x);
                pg8::EpiPlain<false> E{WSP(WS_BIG), 6144};
                pg8::gemm_phase<pg8::EpiPlain<false>, pg8::StaticOrder, true, true>(F.lds, g, S, E, F.tid);
            } SEAM(base + 0);
            if (EN_ROT && IN(base + 1)) { REFRESH(); rotary_phase(F); } SEAM(base + 1);
            if (EN_ATT && IN(base + 2)) { REFRESH(); attention_phase(F, args, j, li == 0 ? 0.2f : 0.4707130183435842f); } SEAM(base + 2);
            if (EN_SUB && !(ATT16 && ATT16_SUBLN) && IN(base + 3)) { REFRESH(); subln_phase(F, args, j, li == 0 ? 0.8f : 0.5292869816564158f); }
#if !(ATT16 && ATT16_SUBLN) || MK_PER_PHASE
            SEAM(base + 3);
#endif
            if (EN_GEMM && IN(base + 4)) { REFRESH();
                pg8::Gemm g{OUTP((size_t)MROWS * DM), WSP(WS_W_AOUT) + (size_t)j * DM * DM, MROWS, DM, DM};
#if FUSE_NORM
                constexpr int S_N = DM; MK_NORM_ORDER(S, 1, li * 2, li, 0, li, 1);
                pg8::EpiPlain<true> E{WSP(WS_MIX), DM};
                pg8::gemm_phase<pg8::EpiPlain<true>, NormOrder<1>, true, true>(F.lds, g, S, E, F.tid);
#else
                pg8::StaticOrder S; S.init(MROWS, DM, F.G, (int)blockIdx.x);
                pg8::EpiPlain<false> E{WSP(WS_MIX), DM};
                pg8::gemm_phase<pg8::EpiPlain<false>, pg8::StaticOrder, true, true>(F.lds, g, S, E, F.tid);
#endif
            } SEAM(base + 4);
        } else {
            if (EN_S5A && IN(base + 0)) { REFRESH(); s5_phaseA(F, args, j); } SEAM(base + 0);
            if (EN_S5B && IN(base + 1)) { REFRESH(); s5_phaseB(F, args, j); } SEAM(base + 1);
            if (EN_S5C && IN(base + 2)) { REFRESH(); s5_phaseC(F, args, j); }
            SEAM2(base + 2);
            if (EN_GEMM && IN(base + 4)) { REFRESH();
                pg8::Gemm g{OUTP((size_t)MROWS * DM), WSP(WS_W_GLU) + (size_t)j * 4096 * DM, MROWS, 4096, DM};
#if FUSE_NORM
                constexpr int S_N = 4096; MK_NORM_ORDER(S, 1, li * 2, li, 0, li, 1);
                pg8::EpiGated<1, true> E{WSP(WS_MIX), DM};
                pg8::gemm_phase<pg8::EpiGated<1, true>, NormOrder<1>, true, true>(F.lds, g, S, E, F.tid);
#else
                pg8::StaticOrder S; S.init(MROWS, 4096, F.G, (int)blockIdx.x);
                pg8::EpiGated<1, false> E{WSP(WS_MIX), DM};
                pg8::gemm_phase<pg8::EpiGated<1, false>, pg8::StaticOrder, true, true>(F.lds, g, S, E, F.tid);
#endif
            } SEAM(base + 4);
        }
#if !FUSE_NORM
        if (EN_NORM && IN(base + 5)) { REFRESH(); norm_phase<1>(F, args, li, 0, li, 1); } SEAM(base + 5);
#endif
        if (EN_GEMM && IN(base + 6)) { REFRESH();
            pg8::Gemm g{OUTP(0), WSP(WS_W_FIN) + (size_t)li * 2 * FF * DM, MROWS, 2 * FF, DM}; pg8::StaticOrder S; S.init(MROWS, 2 * FF, F.G, (int)blockIdx.x);
            pg8::EpiGated<0> E{WSP(WS_BIG), FF};
            pg8::gemm_phase<pg8::EpiGated<0>, pg8::StaticOrder, true, true>(F.lds, g, S, E, F.tid);
        } SEAM(base + 6);
        if (EN_GEMM && IN(base + 7)) { REFRESH();
            pg8::Gemm g{WSP(WS_BIG), WSP(WS_W_FOUT) + (size_t)li * DM * FF, MROWS, DM, FF};
#if FUSE_NORM
            constexpr int S_N = DM; MK_NORM_ORDER(S, 1, li * 2 + 1, li, 1, (li < NLAYER - 1 ? li + 1 : li), 0);
            pg8::EpiPlain<true> E{WSP(WS_MIX), DM};
            pg8::gemm_phase<pg8::EpiPlain<true>, NormOrder<1>, true, true>(F.lds, g, S, E, F.tid);
#else
            pg8::StaticOrder S; S.init(MROWS, DM, F.G, (int)blockIdx.x);
            pg8::EpiPlain<false> E{WSP(WS_MIX), DM};
            pg8::gemm_phase<pg8::EpiPlain<false>, pg8::StaticOrder, true, true>(F.lds, g, S, E, F.tid);
#endif
        }
#if FUSE_NORM
        if (li < NLAYER - 1) SEAM(base + 7);
#else
        SEAM(base + 7);
        if (EN_NORM && IN(base + 8)) { REFRESH(); if (li < NLAYER - 1) norm_phase<1>(F, args, li, 1, li + 1, 0); else norm_phase<2>(F, args, li, 1, 0, 0); }
        if (li < NLAYER - 1) SEAM(base + 8);
#endif
    }
#if DBG_DUMP
    if (!MK_PER_PHASE || hi == N_PHASES) {
        if (!MK_PER_PHASE || hi - lo > 1) xcd_barrier(bar);
        REFRESH();
        const size_t n = (size_t)MROWS * DM; float* o = args.out;
        for (size_t i = (size_t)F.gw * 64 + F.lane; i < n; i += (size_t)F.NGW * 64) {
            const size_t m = i / DM, c = i % DM; float v = 0.f;
            if (DBG_DUMP == 1) v = bf_lo(HBUF(F)[i]);
            if (DBG_DUMP == 2) v = bf_lo(ATTBUF(F)[i]);
            if (DBG_DUMP == 3) v = bf_lo(((const bf16*)(F.ws + WS_MIX))[i]);
            if (DBG_DUMP == 4) v = bf_lo(((const bf16*)(F.ws + WS_BIG))[m * 6144 + c]);
            if (DBG_DUMP == 5) v = bf_lo(((const bf16*)(F.ws + WS_BIG))[m * 6144 + 2048 + c]);
            if (DBG_DUMP == 6) v = bf_lo(((const bf16*)(F.ws + WS_BIG))[m * 6144 + 4096 + c]);
            if (DBG_DUMP == 7) v = (c < 1024) ? ((const float*)(F.ws + WS_MIX))[m * 1024 + c] : 0.f;
            if (DBG_DUMP == 8) v = bf_lo(((const bf16*)(F.ws + WS_BIG))[m * FF + c]);
            if (DBG_DUMP == 9) v = bf_lo(((const bf16*)(F.ws + WS_BIG))[m * FF + 2048 + c]);
            if (DBG_DUMP == 10) v = (c < 1536) ? bf_lo(((const bf16*)(F.ws + WS_BIG))[m * FF + 4096 + c]) : 0.f;
            if (DBG_DUMP == 11) v = (i < S5_STATE_BYTES / 4) ? ((const float*)(F.ws + WS_S5E))[i] : 0.f;
            if (DBG_DUMP == 12) v = (i < S5_STATE_BYTES / 4) ? ((const float*)(F.ws + WS_S5X))[i] : 0.f;
            if (DBG_DUMP == 13) v = (i < 4 * NSEQ * 12288) ? ((const float*)(F.ws + WS_ADA))[i] : ((i < 4 * NSEQ * 12288 + T_PROMPT * 32) ? ((const float*)(F.ws + WS_ROT))[i - 4 * NSEQ * 12288] : 0.f);
            o[i] = v;
        }
    }
#endif
#undef IN
#undef SEAM
}

extern "C" void kernel_launch(void* const* d_in, const int* in_sizes, int n_in, void* d_out, int out_size, void* d_ws, size_t ws_size, hipStream_t stream) {
    static int grid = 0;
    if (grid == 0) {
        if (n_in != 26 || out_size != MROWS * DM || in_sizes[0] != ROWS_PROMPT * DM || ws_size < WS_END) {
            fprintf(stderr, "kernel_launch: shape mismatch (n_in %d, out %d, in0 %d, ws %zu; need ws >= %zu); nothing launched\n", n_in, out_size, n_in > 0 ? in_sizes[0] : -1, ws_size, (size_t)WS_END); grid = -1; return; }
        int dev = 0, cus = 0;
        if (hipGetDevice(&dev) != hipSuccess || hipDeviceGetAttribute(&cus, hipDeviceAttributeMultiprocessorCount, dev) != hipSuccess) { fprintf(stderr, "kernel_launch: device query failed\n"); grid = -1; return; }
        if (hipFuncSetAttribute((const void*)trunk_fwd, hipFuncAttributeMaxDynamicSharedMemorySize, LDS_BYTES) != hipSuccess) { fprintf(stderr, "kernel_launch: hipFuncSetAttribute failed\n"); grid = -1; return; }
        int per_cu = 0;
        if (hipOccupancyMaxActiveBlocksPerMultiprocessor(&per_cu, (const void*)trunk_fwd, NWAVES * 64, LDS_BYTES) != hipSuccess || per_cu < 1)
            fprintf(stderr, "kernel_launch: note: occupancy query reports %d workgroups per CU\n", per_cu);
        (void)hipGetLastError();
        grid = cus;
        if (FUSE_NORM && grid != 256) { fprintf(stderr, "kernel_launch: this build's fused norm passes need exactly 256 workgroups (one per CU of a 256-CU device); device has %d CUs; nothing launched\n", cus); grid = -1; return; }
    }
    if (grid < 0) return;
    if (hipMemsetAsync((char*)d_ws + WS_CTL, 0, CTL_ZERO_BYTES, stream) != hipSuccess) { fprintf(stderr, "kernel_launch: memset failed\n"); return; }
    Args a{};
    for (int i = 0; i < 26; ++i) a.in[i] = (const float*)d_in[i];
    a.out = (float*)d_out; a.ws = (unsigned char*)d_ws;
#if MK_PER_PHASE
    for (int k = 0; k < N_PHASES; ++k) {
        if (k >= 2) { const int li = (k - 2) / PH_PER_LAYER, kk = (k - 2) % PH_PER_LAYER; if ((li & 1) && kk == 3) continue; if (FUSE_NORM && (kk == 5 || kk == 8)) continue; }
        a.ph_lo = k; a.ph_hi = k + 1;
        int reps = 1;
        if (k == 0) reps = HREP_P0;
        if (k == 1) reps = HREP_P1;
        if (k >= 2) { const int li = (k - 2) / PH_PER_LAYER, kk = (k - 2) % PH_PER_LAYER;
            if (kk == 6) reps = HREP_FIN; if (kk == 7) reps = HREP_FOUT;
            if (!(li & 1)) { if (kk == 0) reps = HREP_INP; if (kk == 2) reps = HREP_ATT; if (kk == 4) reps = HREP_OUTP; }
            else { if (kk <= 2) reps = HREP_S5; if (kk == 4) reps = HREP_GLU; } }
        for (int r = 0; r < reps; ++r) hipLaunchKernelGGL(trunk_fwd, dim3(grid), dim3(NWAVES * 64), LDS_BYTES, stream, a);
    }
#else
    a.ph_lo = 0; a.ph_hi = N_PHASES;
    hipLaunchKernelGGL(trunk_fwd, dim3(grid), dim3(NWAVES * 64), LDS_BYTES, stream, a);
#endif
    const hipError_t le = hipPeekAtLastError();
    if (le != hipSuccess) fprintf(stderr, "kernel_launch: launch failed: %s\n", hipGetErrorName(le));
}
```
